# Optimizing an MI355X kernel written in HIP

```python
import math
import jax
import jax.numpy as jnp
from jax import lax
import numpy as np

D_MODEL = 2048
BATCH = 4
SEQ = 2048
DEPTH = 4

GRID_W = 64
CTX_LEN = 256
HEAD_DIM = 128
N_HEADS_TOTAL = D_MODEL // HEAD_DIM
MLA_HEADS = N_HEADS_TOTAL // 2
MLA_NOPE_DIM = 128
MLA_ROPE_DIM = 64
MLA_QK_DIM = MLA_NOPE_DIM + MLA_ROPE_DIM
MLA_V_DIM = HEAD_DIM
MLA_KV_RANK = 512
NA_HEADS = N_HEADS_TOTAL - MLA_HEADS
NA_DIM = HEAD_DIM
NA_KH = 8
NA_KW = 16
EV_IN_WIDTH = MLA_HEADS * MLA_QK_DIM + MLA_KV_RANK + MLA_ROPE_DIM + 3 * NA_HEADS * NA_DIM
ATTN_BLOCK = 128
ROPE_THETA = 10000.0
HGRN_WIDTH = D_MODEL // 2
HGRN_HEADS = HGRN_WIDTH // HEAD_DIM
HGRN_DK = HEAD_DIM
HGRN_DV = HEAD_DIM
HGRN_CHUNK = 64
FORGET_FLOOR = 1e-30
HYENA_WIDTH = D_MODEL - HGRN_WIDTH
HYENA_SHORT = 3
HYENA_EMB = 33
HYENA_BANDS = (HYENA_EMB - 1) // 2
HYENA_FILT_HIDDEN = 64
HYENA_DECAY_TARGET = 1e-2
HYENA_FAST_PCT = 0.3
HYENA_SLOW_PCT = 1.5
OD_IN_WIDTH = 5 * HGRN_WIDTH + 3 * HYENA_WIDTH
MLP_HIDDEN = 4 * D_MODEL
N_EVEN = (DEPTH + 1) // 2
N_ODD = DEPTH // 2
NORM_EPS = 1e-6
NEG_INF = -1e30
F32 = jnp.float32

kernel_name = "hybrid_mla_natten_hgrn2_hyena_dit"


def rmsnorm(x, g):
    xf = x.astype(F32)
    y = xf * lax.rsqrt(jnp.mean(xf * xf, axis=-1, keepdims=True) + NORM_EPS)
    return (y * g.astype(F32)).astype(x.dtype)


def modulate(x, shift, scale):
    return x * (1.0 + scale) + shift


def rope_1d(x, pos):
    d = x.shape[-1]
    inv_freq = ROPE_THETA ** (-jnp.arange(0, d, 2, dtype=F32) / d)
    ang = pos.astype(F32)[:, None] * inv_freq[None, :]
    cos, sin = jnp.cos(ang)[:, None, :], jnp.sin(ang)[:, None, :]
    x1, x2 = x[..., : d // 2].astype(F32), x[..., d // 2:].astype(F32)
    return jnp.concatenate([x1 * cos - x2 * sin, x2 * cos + x1 * sin], -1).astype(x.dtype)


def rope_2d(x, rows, cols):
    half = x.shape[-1] // 2
    return jnp.concatenate([rope_1d(x[..., :half], rows), rope_1d(x[..., half:], cols)], -1)


def softmax_attend(q, k, v, scale):
    s = jnp.einsum("bhqd,bhkd->bhqk", q, k).astype(F32) * scale
    p = jax.nn.softmax(s, axis=-1).astype(v.dtype)
    return jnp.einsum("bhqk,bhke->bhqe", p, v)


def blocked_attend(q, k, v, scale):
    b, h, n_q, d = q.shape
    n_blk = n_q // ATTN_BLOCK
    qb = q.reshape(b, h, n_blk, ATTN_BLOCK, d).transpose(2, 0, 1, 3, 4)
    ob = lax.map(lambda qi: softmax_attend(qi, k, v, scale), qb)
    return ob.transpose(1, 2, 0, 3, 4).reshape(b, h, n_q, v.shape[-1])


def merge_heads(*outs):
    return jnp.concatenate([o.transpose(0, 2, 1, 3).reshape(o.shape[0], o.shape[2], -1) for o in outs], -1)


def even_heads(p, kv_norm_g, w_ukv, grid_pos):
    b, n, _ = p.shape
    sizes = [MLA_HEADS * MLA_QK_DIM, MLA_KV_RANK, MLA_ROPE_DIM, NA_HEADS * NA_DIM, NA_HEADS * NA_DIM]
    cuts = [int(s) for s in np.cumsum(sizes)]
    q_mla, c_kv, k_pe, q_na, k_na, v_na = jnp.split(p, cuts, axis=-1)
    q = q_mla.reshape(b, n, MLA_HEADS, MLA_QK_DIM)
    q_nope, q_pe = q[..., :MLA_NOPE_DIM], q[..., MLA_NOPE_DIM:]
    k_pe = k_pe[:, :, None, :]
    if grid_pos is not None:
        q_pe = rope_2d(q_pe, *grid_pos)
        k_pe = rope_2d(k_pe, *grid_pos)
    kv = (rmsnorm(c_kv, kv_norm_g) @ w_ukv).reshape(b, n, MLA_HEADS, MLA_NOPE_DIM + MLA_V_DIM)
    k_nope, v = kv[..., :MLA_NOPE_DIM], kv[..., MLA_NOPE_DIM:]
    q = jnp.concatenate([q_nope, q_pe], -1)
    k = jnp.concatenate([k_nope, jnp.broadcast_to(k_pe, (b, n, MLA_HEADS, MLA_ROPE_DIM))], -1)
    bhld = lambda t: t.transpose(0, 2, 1, 3)
    na = lambda t: t.reshape(b, n, NA_HEADS, NA_DIM).transpose(0, 2, 1, 3)
    return bhld(q), bhld(k), bhld(v), na(q_na), na(k_na), na(v_na)


def neighbourhood_attend(q, k, v, k_ctx, v_ctx, rel_bias):
    b, h, n, d = q.shape
    n_rows = n // GRID_W
    kh = min(NA_KH, n_rows)
    r = np.arange(n_rows)
    col = np.arange(GRID_W)
    row_idx = np.clip(r - kh // 2, 0, n_rows - kh)[:, None] + np.arange(kh)[None, :]
    col_start = np.clip(col - NA_KW // 2, 0, GRID_W - NA_KW)
    col_mask = (col[None, :] >= col_start[:, None]) & (col[None, :] < col_start[:, None] + NA_KW)
    row_off = row_idx - r[:, None] + (NA_KH - 1)
    col_off = np.clip(col[None, :] - col[:, None], 1 - NA_KW, NA_KW - 1) + (NA_KW - 1)
    qg = q.reshape(b, h, n_rows, GRID_W, d)
    k_band = k.reshape(b, h, n_rows, GRID_W, d)[:, :, row_idx]
    v_band = v.reshape(b, h, n_rows, GRID_W, d)[:, :, row_idx]
    scale = d ** -0.5
    bias = rel_bias[:, row_off[:, None, :, None], col_off[None, :, None, :]].astype(F32)
    s_nb = jnp.einsum("bhrqd,bhrkwd->bhrqkw", qg, k_band).astype(F32) * scale + bias
    s_nb = jnp.where(col_mask[:, None, :], s_nb, NEG_INF)
    s_ctx = jnp.einsum("bhrqd,bhcd->bhrqc", qg, k_ctx).astype(F32) * scale
    s = jnp.concatenate([s_nb.reshape(b, h, n_rows, GRID_W, kh * GRID_W), s_ctx], -1)
    p = jax.nn.softmax(s, axis=-1).astype(v.dtype)
    p_nb = p[..., : kh * GRID_W].reshape(b, h, n_rows, GRID_W, kh, GRID_W)
    o = (jnp.einsum("bhrqkw,bhrkwd->bhrqd", p_nb, v_band)
         + jnp.einsum("bhrqc,bhcd->bhrqd", p[..., kh * GRID_W:], v_ctx))
    return o.reshape(b, h, n, d)


def even_mixer(a_lat, a_ctx, w_in, kv_norm_g, w_ukv, rel_bias, ctx_out):
    n = a_lat.shape[1]
    pos = jnp.arange(n)
    grid = (pos // GRID_W, pos % GRID_W)
    q_l, k_l, v_l, qn_l, kn_l, vn_l = even_heads(a_lat @ w_in, kv_norm_g, w_ukv, grid)
    q_c, k_c, v_c, qn_c, kn_c, vn_c = even_heads(a_ctx @ w_in, kv_norm_g, w_ukv, None)
    mla_scale = MLA_QK_DIM ** -0.5
    o_mla = blocked_attend(q_l, jnp.concatenate([k_c, k_l], 2), jnp.concatenate([v_c, v_l], 2), mla_scale)
    o_na = neighbourhood_attend(qn_l, kn_l, vn_l, kn_c, vn_c, rel_bias)
    y_lat = merge_heads(o_mla, o_na)
    if not ctx_out:
        return y_lat, None
    y_ctx = merge_heads(softmax_attend(q_c, k_c, v_c, mla_scale),
                        softmax_attend(qn_c, kn_c, vn_c, NA_DIM ** -0.5))
    return y_lat, y_ctx


def gla_chunked(q, v, log_f, s0):
    b, h, n, dk = q.shape
    dv = v.shape[-1]
    n_chunks = n // HGRN_CHUNK
    k = -jnp.expm1(log_f)
    chunks = lambda t: t.reshape(b, h, n_chunks, HGRN_CHUNK, t.shape[-1]).transpose(2, 0, 1, 3, 4)
    causal = jnp.tril(jnp.ones((HGRN_CHUNK, HGRN_CHUNK), dtype=bool))[:, :, None]

    def step(state, inp):
        qc, kc, vc, fc = inp
        cum = jnp.cumsum(fc, axis=2)
        diff = jnp.where(causal, cum[:, :, :, None, :] - cum[:, :, None, :, :], 0.0)
        decay = jnp.where(causal, jnp.exp(diff), 0.0)
        scores = jnp.einsum("bhtd,bhsd,bhtsd->bhts", qc, kc, decay)
        o = (jnp.einsum("bhtd,bhde->bhte", qc * jnp.exp(cum), state)
             + jnp.einsum("bhts,bhse->bhte", scores, vc))
        last = cum[:, :, -1:, :]
        state = (jnp.exp(last[:, :, 0, :])[..., None] * state
                 + jnp.einsum("bhsd,bhse->bhde", kc * jnp.exp(last - cum), vc))
        return state, o

    s_fin, o = lax.scan(step, s0, (chunks(q), chunks(k), chunks(v), chunks(log_f)))
    return o.transpose(1, 2, 0, 3, 4).reshape(b, h, n, dv), s_fin


def log_forget(z, lb):
    f = lb + (1.0 - lb) * jax.nn.sigmoid(z.astype(F32))
    return jnp.log(jnp.maximum(f, FORGET_FLOOR))


def hgrn2_bidir(p_lat, p_ctx, lb_fwd, lb_bwd, norm_g, ctx_out):
    def heads(t):
        b_, n_, _ = t.shape
        return t.astype(F32).reshape(b_, n_, HGRN_HEADS, -1).transpose(0, 2, 1, 3)

    def prep(p):
        q, i, zf, zb, g = jnp.split(p, 5, axis=-1)
        return (heads(jax.nn.silu(q)), heads(i), heads(log_forget(zf, lb_fwd)),
                heads(log_forget(zb, lb_bwd)), g)

    def readout(o, g):
        b_, h_, n_, dv = o.shape
        o = rmsnorm(o, norm_g.reshape(HGRN_HEADS, 1, HGRN_DV)).transpose(0, 2, 1, 3).reshape(b_, n_, h_ * dv)
        return (o * jax.nn.silu(g.astype(F32))).astype(g.dtype)

    rev = lambda t: jnp.flip(t, axis=2)
    q_l, i_l, lff_l, lfb_l, g_l = prep(p_lat)
    q_c, i_c, lff_c, lfb_c, g_c = prep(p_ctx)
    s0 = jnp.zeros((p_ctx.shape[0], HGRN_HEADS, HGRN_DK, HGRN_DV), F32)
    o_cf, s_cf = gla_chunked(q_c, i_c, lff_c, s0)
    o_lf, _ = gla_chunked(q_l, i_l, lff_l, s_cf)
    o_cb, s_cb = gla_chunked(rev(q_c), rev(i_c), rev(lfb_c), s0)
    o_lb, _ = gla_chunked(rev(q_l), rev(i_l), rev(lfb_l), s_cb)
    y_lat = readout(o_lf + rev(o_lb), g_l)
    y_ctx = readout(o_cf + rev(o_cb), g_c) if ctx_out else None
    return y_lat, y_ctx


def short_conv(u, w, bias):
    n = u.shape[1]
    pad = HYENA_SHORT // 2
    up = jnp.pad(u, ((0, 0), (pad, HYENA_SHORT - 1 - pad), (0, 0)))
    out = bias
    for j in range(HYENA_SHORT):
        out = out + up[:, j:j + n] * w[j]
    return out


def hyena_filter(n, w1, b1, w2, b2, w3, b3, freq, w_out):
    pos = jnp.arange(n, dtype=F32)
    t = pos / max(n - 1, 1)
    bands = jnp.linspace(1e-4, HYENA_BANDS - 1, HYENA_BANDS, dtype=F32)
    ang = (2.0 * math.pi / n) * pos[:, None] * bands[None, :]
    z = jnp.concatenate([t[:, None], jnp.cos(ang), -jnp.sin(ang)], -1)
    fr = freq.astype(F32)
    hdn = jnp.sin(fr * (z @ w1.astype(F32) + b1.astype(F32)))
    hdn = jnp.sin(fr * (hdn @ w2.astype(F32) + b2.astype(F32)))
    hdn = jnp.sin(fr * (hdn @ w3.astype(F32) + b3.astype(F32)))
    filt = hdn @ w_out.astype(F32)
    max_decay = math.log(HYENA_DECAY_TARGET) / HYENA_FAST_PCT
    min_decay = math.log(HYENA_DECAY_TARGET) / HYENA_SLOW_PCT
    deltas = jnp.abs(jnp.linspace(min_decay, max_decay, HYENA_WIDTH, dtype=F32))
    window = jnp.exp(-t[:, None] * deltas[None, :])
    return filt[:, :HYENA_WIDTH] * window, filt[:, HYENA_WIDTH:] * window


def long_conv_bidir(v, h_fwd, h_bwd, skip):
    n, ch = h_fwd.shape
    k = jnp.concatenate([h_fwd, jnp.zeros((1, ch), F32), h_bwd[:0:-1]], axis=0)
    vf = v.astype(F32)
    y = jnp.fft.irfft(jnp.fft.rfft(vf, n=2 * n, axis=1) * jnp.fft.rfft(k, axis=0)[None],
                      n=2 * n, axis=1)[:, :n]
    return (y + vf * skip.astype(F32)).astype(v.dtype)


def hyena(u, conv_w, conv_b, filt, skip):
    n = u.shape[1]
    x0, x1, v = jnp.split(short_conv(u, conv_w, conv_b), 3, axis=-1)
    h_fwd, h_bwd = hyena_filter(n, *filt)
    return x0 * long_conv_bidir(v * x1, h_fwd, h_bwd, skip)


def odd_mixer(a_lat, a_ctx, w_in, lb_fwd, lb_bwd, norm_g, conv_w, conv_b, filt, skip, ctx_out):
    split_at = 5 * HGRN_WIDTH
    p_lat = a_lat @ w_in
    p_ctx = a_ctx @ (w_in if ctx_out else w_in[:, :split_at])
    hg_lat, hg_ctx = hgrn2_bidir(p_lat[..., :split_at], p_ctx[..., :split_at], lb_fwd, lb_bwd, norm_g, ctx_out)
    y_lat = jnp.concatenate([hg_lat, hyena(p_lat[..., split_at:], conv_w, conv_b, filt, skip)], -1)
    if not ctx_out:
        return y_lat, None
    y_ctx = jnp.concatenate([hg_ctx, hyena(p_ctx[..., split_at:], conv_w, conv_b, filt, skip)], -1)
    return y_lat, y_ctx


def sq_relu_mlp(h, w1, w2):
    return jnp.square(jax.nn.relu(h @ w1)) @ w2


def setup_inputs(seed: int = 0) -> dict:
    key = jax.random.key(seed)
    ks = jax.random.split(key, 32)
    D = D_MODEL

    def nrm(k, shape, scale):
        return jax.random.normal(k, shape, F32) * scale

    return {
        "x": nrm(ks[0], (BATCH, SEQ, D), 1.0),
        "c": nrm(ks[1], (BATCH, D), 1.0),
        "ctx": nrm(ks[2], (BATCH, CTX_LEN, D), 1.0),
        "c_ctx": nrm(ks[3], (D,), 1.0),
        "ada_w": nrm(ks[4], (DEPTH, D, 6 * D), 0.5 * D ** -0.5),
        "ada_b": nrm(ks[5], (DEPTH, 6 * D), 0.02),
        "norm_mix_g": 1.0 + nrm(ks[6], (DEPTH, D), 0.02),
        "norm_mlp_g": 1.0 + nrm(ks[7], (DEPTH, D), 0.02),
        "w_out": nrm(ks[8], (DEPTH, D, D), D ** -0.5),
        "mlp_w1": nrm(ks[9], (DEPTH, D, MLP_HIDDEN), D ** -0.5),
        "mlp_w2": nrm(ks[10], (DEPTH, MLP_HIDDEN, D), MLP_HIDDEN ** -0.5),
        "final_norm_g": 1.0 + nrm(ks[11], (D,), 0.02),
        "ev_w_in": nrm(ks[12], (N_EVEN, D, EV_IN_WIDTH), D ** -0.5),
        "mla_kv_norm_g": 1.0 + nrm(ks[13], (N_EVEN, MLA_KV_RANK), 0.02),
        "mla_w_ukv": nrm(ks[14], (N_EVEN, MLA_KV_RANK, MLA_HEADS * (MLA_NOPE_DIM + MLA_V_DIM)), MLA_KV_RANK ** -0.5),
        "na_rel_bias": nrm(ks[15], (N_EVEN, NA_HEADS, 2 * NA_KH - 1, 2 * NA_KW - 1), 0.1),
        "od_w_in": nrm(ks[16], (N_ODD, D, OD_IN_WIDTH), D ** -0.5),
        "hgrn_lb_logits": nrm(ks[17], (2, N_ODD, HGRN_WIDTH), 0.5),
        "hgrn_norm_g": 1.0 + nrm(ks[18], (N_ODD, HGRN_WIDTH), 0.02),
        "hy_conv_w": nrm(ks[19], (N_ODD, HYENA_SHORT, 3 * HYENA_WIDTH), HYENA_SHORT ** -0.5),
        "hy_conv_b": nrm(ks[20], (N_ODD, 3 * HYENA_WIDTH), 0.02),
        "hy_filt_w1": nrm(ks[21], (N_ODD, HYENA_EMB, HYENA_FILT_HIDDEN), HYENA_EMB ** -0.5),
        "hy_filt_b1": nrm(ks[22], (N_ODD, HYENA_FILT_HIDDEN), 0.1),
        "hy_filt_w2": nrm(ks[23], (N_ODD, HYENA_FILT_HIDDEN, HYENA_FILT_HIDDEN), HYENA_FILT_HIDDEN ** -0.5),
        "hy_filt_b2": nrm(ks[24], (N_ODD, HYENA_FILT_HIDDEN), 0.1),
        "hy_filt_w3": nrm(ks[25], (N_ODD, HYENA_FILT_HIDDEN, HYENA_FILT_HIDDEN), HYENA_FILT_HIDDEN ** -0.5),
        "hy_filt_b3": nrm(ks[26], (N_ODD, HYENA_FILT_HIDDEN), 0.1),
        "hy_filt_freq": 1.0 + nrm(ks[27], (N_ODD, HYENA_FILT_HIDDEN), 0.1),
        "hy_filt_wout": nrm(ks[28], (N_ODD, HYENA_FILT_HIDDEN, 2 * HYENA_WIDTH), 0.1 * HYENA_FILT_HIDDEN ** -0.5),
        "hy_skip": nrm(ks[29], (N_ODD, HYENA_WIDTH), 0.5),
    }


def reference(x, c, ctx, c_ctx, ada_w, ada_b, norm_mix_g, norm_mlp_g, w_out, mlp_w1, mlp_w2,
              final_norm_g, ev_w_in, mla_kv_norm_g, mla_w_ukv, na_rel_bias, od_w_in,
              hgrn_lb_logits, hgrn_norm_g, hy_conv_w, hy_conv_b, hy_filt_w1, hy_filt_b1,
              hy_filt_w2, hy_filt_b2, hy_filt_w3, hy_filt_b3, hy_filt_freq, hy_filt_wout, hy_skip):
    lb_p = jax.nn.softmax(hgrn_lb_logits.astype(F32), axis=1)
    lower_bounds = jnp.cumsum(lb_p, axis=1) - lb_p[:, :1]
    h_lat, h_ctx = x, ctx
    for l in range(DEPTH):
        ctx_out = l < DEPTH - 1
        mod_lat = jax.nn.silu(c) @ ada_w[l] + ada_b[l]
        sh_a, sc_a, g_a, sh_m, sc_m, g_m = [t[:, None, :] for t in jnp.split(mod_lat, 6, axis=-1)]
        mod_ctx = jax.nn.silu(c_ctx) @ ada_w[l] + ada_b[l]
        csh_a, csc_a, cg_a, csh_m, csc_m, cg_m = jnp.split(mod_ctx, 6, axis=-1)
        a_lat = modulate(rmsnorm(h_lat, norm_mix_g[l]), sh_a, sc_a)
        a_ctx = modulate(rmsnorm(h_ctx, norm_mix_g[l]), csh_a, csc_a)
        if l % 2 == 0:
            e = l // 2
            y_lat, y_ctx = even_mixer(a_lat, a_ctx, ev_w_in[e], mla_kv_norm_g[e], mla_w_ukv[e],
                                      na_rel_bias[e], ctx_out)
        else:
            o = l // 2
            filt = (hy_filt_w1[o], hy_filt_b1[o], hy_filt_w2[o], hy_filt_b2[o], hy_filt_w3[o],
                    hy_filt_b3[o], hy_filt_freq[o], hy_filt_wout[o])
            y_lat, y_ctx = odd_mixer(a_lat, a_ctx, od_w_in[o], lower_bounds[0, o], lower_bounds[1, o],
                                     hgrn_norm_g[o], hy_conv_w[o], hy_conv_b[o], filt, hy_skip[o], ctx_out)
        h_lat = h_lat + g_a * (y_lat @ w_out[l])
        h_lat = h_lat + g_m * sq_relu_mlp(modulate(rmsnorm(h_lat, norm_mlp_g[l]), sh_m, sc_m),
                                          mlp_w1[l], mlp_w2[l])
        if ctx_out:
            h_ctx = h_ctx + cg_a * (y_ctx @ w_out[l])
            h_ctx = h_ctx + cg_m * sq_relu_mlp(modulate(rmsnorm(h_ctx, norm_mlp_g[l]), csh_m, csc_m),
                                               mlp_w1[l], mlp_w2[l])
    return rmsnorm(h_lat, final_norm_g)
```

```cpp
#include <hip/hip_runtime.h>
#include <stdint.h>
#include <stdio.h>
#include <string.h>

#ifndef MK_MULTI
#define MK_MULTI 0
#endif

constexpr int D = 2048, NB = 4, SEQ = 2048, CTXL = 256, DEPTH = 4;
constexpr int MLAT = NB * SEQ, MCTX = NB * CTXL, MTOT = MLAT + MCTX;
constexpr int EVW = 5184, EVP = 5376, ODW = 8192, HID = 8192;
constexpr int NTHR = 512;
constexpr float NORM_EPS = 1e-6f;

#define XB_TMO      128
#define XB_XCNT(j)  (256  + 64 * (j))
#define XB_XSUB(j)  (1280 + 64 * (j))
#define XB_XGEN(j)  (2304 + 64 * (j))
#define XB_TOP      3328
#define XB_TOPGEN   3392
#define XCD_BAR_WORDS 3456
#define XB_SPIN_CAP (1u << 23)
#define LAS __attribute__((address_space(3)))

__device__ __forceinline__ unsigned xb_ld(unsigned* p)              { return __hip_atomic_load(p, __ATOMIC_RELAXED, __HIP_MEMORY_SCOPE_AGENT); }
__device__ __forceinline__ unsigned xb_add(unsigned* p, unsigned v) { return __hip_atomic_fetch_add(p, v, __ATOMIC_RELAXED, __HIP_MEMORY_SCOPE_AGENT); }
__device__ __forceinline__ unsigned xb_xcc_id() { return (unsigned)__builtin_amdgcn_s_getreg((3 << 11) | 20) & 0xFu; }
#define XB_SPIN(cond, bar) do { unsigned _sp = 0; while (cond) { __builtin_amdgcn_s_sleep(1); \
    if ((++_sp & 255u) == 0u) { if (xb_ld(&(bar)[XB_TMO])) break; if (_sp > XB_SPIN_CAP) { atomicAdd(&(bar)[XB_TMO], 1u); break; } } } } while (0)

struct XcdBarrier { unsigned* bar; unsigned x; volatile LAS unsigned* st; };

__device__ __forceinline__ XcdBarrier xcd_barrier_post(unsigned* bar, volatile LAS unsigned* st) {
    XcdBarrier b; b.bar = bar; b.x = xb_xcc_id(); b.st = st;
    if (threadIdx.x == 0) (void)xb_add(&bar[XB_XCNT(b.x)], 1u);
    return b;
}
__device__ __forceinline__ void xcd_barrier_complete(unsigned* bar, unsigned x, unsigned& nloc, unsigned& nx) {
    const unsigned G = gridDim.x * gridDim.y * gridDim.z;
    unsigned sum, cnt, mine, sp = 0u;
    for (;;) {
        sum = 0u; cnt = 0u; mine = 0u;
#pragma unroll
        for (unsigned j = 0; j < 16; ++j) { const unsigned c = xb_ld(&bar[XB_XCNT(j)]); sum += c; cnt += (c > 0u) ? 1u : 0u; mine = (j == x) ? c : mine; }
        if (sum == G) break;
        __builtin_amdgcn_s_sleep(1);
        if ((++sp & 255u) == 0u) { if (xb_ld(&bar[XB_TMO])) break; if (sp > XB_SPIN_CAP) { atomicAdd(&bar[XB_TMO], 1u); break; } }
    }
    nloc = mine > 0u ? mine : 1u; nx = cnt > 0u ? cnt : 1u;
}
__device__ __forceinline__ void xcd_barrier(const XcdBarrier& b) {
    asm volatile("s_waitcnt vmcnt(0)" ::: "memory");
    __syncthreads();
    if (threadIdx.x == 0) {
        unsigned* bar = b.bar;
        __builtin_amdgcn_s_waitcnt(0);
        unsigned nloc = b.st[0], nx = b.st[1];
        if (nloc == 0u) { xcd_barrier_complete(bar, b.x, nloc, nx); b.st[0] = nloc; b.st[1] = nx; }
        const unsigned old = xb_add(&bar[XB_XSUB(b.x)], 1u);
        const unsigned gen = old / nloc;
        if (old + 1u == (gen + 1u) * nloc) {
            __builtin_amdgcn_fence(__ATOMIC_RELEASE, "agent");
            asm volatile("s_waitcnt vmcnt(0)" ::: "memory");
            const unsigned og = xb_add(&bar[XB_TOP], 1u);
            const unsigned tg = og / nx;
            if (og + 1u == (tg + 1u) * nx) xb_add(&bar[XB_TOPGEN], 1u);
            else XB_SPIN(xb_ld(&bar[XB_TOPGEN]) == tg, bar);
            __builtin_amdgcn_fence(__ATOMIC_ACQUIRE, "agent");
            xb_add(&bar[XB_XGEN(b.x)], 1u);
            asm volatile("s_waitcnt vmcnt(0)" ::: "memory");
        } else {
            XB_SPIN(xb_ld(&bar[XB_XGEN(b.x)]) == gen, bar);
            __builtin_amdgcn_fence(__ATOMIC_ACQUIRE, "agent");
            asm volatile("s_waitcnt vmcnt(0)" ::: "memory");
        }
    }
    __syncthreads();
}

typedef unsigned short bf16_t;
struct Params {
    const float *x, *c, *ctx, *c_ctx, *ada_w, *ada_b, *norm_mix_g, *norm_mlp_g, *w_out, *mlp_w1, *mlp_w2, *final_norm_g,
        *ev_w_in, *kv_norm_g, *w_ukv, *rel_bias, *od_w_in, *lb_logits, *hgrn_norm_g, *conv_w, *conv_b,
        *fw1, *fb1, *fw2, *fb2, *fw3, *fb3, *ffreq, *fwout, *skip;
    float* out;
    unsigned* bar;
    float *mod, *lb, *rope, *h, *kv, *filt_lat, *filt_ctx, *zb, *x0b, *of, *ob;
    bf16_t *a, *y, *u, *ckvn, *wt_ev, *wt_od, *wt_ukv, *wt_out, *wt_w1, *wt_w2;
    bf16_t *qm, *km, *vm, *qn, *kn, *vn, *p, *ckv, *kpe, *hq, *hu;
    float *he, *ssq;
    float2* kf;
    int ph_lo, ph_hi;
};

typedef const __attribute__((address_space(4))) Params* KP;
__device__ __forceinline__ KP kargs() { KP k = (KP)__builtin_amdgcn_kernarg_segment_ptr(); asm volatile("" : "+s"(k)); return k; }

constexpr size_t al256(size_t x) { return (x + 255) & ~(size_t)255; }
constexpr size_t WS_BAR   = 0;
constexpr size_t WS_MOD   = al256(WS_BAR + XCD_BAR_WORDS * 4);
constexpr size_t WS_LB    = al256(WS_MOD + (size_t)DEPTH * 5 * 6 * D * 4);
constexpr size_t WS_ROPE  = al256(WS_LB + 2 * 2 * 1024 * 4);
constexpr size_t WS_H     = al256(WS_ROPE + 64 * 16 * 2 * 4);
constexpr size_t WS_A     = al256(WS_H + (size_t)MTOT * D * 4);
constexpr size_t WS_P     = al256(WS_A + (size_t)MTOT * D * 2);
constexpr size_t WS_KV    = al256(WS_P + (size_t)MTOT * 8192 * 2);
constexpr size_t WS_CKVN  = al256(WS_KV + (size_t)MTOT * D * 4);
constexpr size_t WS_Y     = al256(WS_CKVN + (size_t)MTOT * 512 * 2);
constexpr size_t WS_U     = al256(WS_Y + (size_t)MTOT * D * 2);
constexpr size_t WS_FLAT  = al256(WS_U + (size_t)MTOT * HID * 2);
constexpr size_t WS_FCTX  = al256(WS_FLAT + (size_t)2 * 2 * SEQ * 1024 * 4);
constexpr size_t WS_ZB    = al256(WS_FCTX + (size_t)2 * 2 * CTXL * 1024 * 4);
constexpr size_t WS_X0B   = al256(WS_ZB + (size_t)MTOT * 1024 * 4);
constexpr size_t WS_OF    = al256(WS_X0B + (size_t)MTOT * 1024 * 4);
constexpr size_t WS_OB    = al256(WS_OF + (size_t)MTOT * 1024 * 4);
constexpr size_t WS_WEV   = al256(WS_OB + (size_t)MTOT * 1024 * 4);
constexpr size_t WS_WOD   = al256(WS_WEV + (size_t)2 * EVP * D * 2);
constexpr size_t WS_WUKV  = al256(WS_WOD + (size_t)2 * ODW * D * 2);
constexpr size_t WS_WOUT  = al256(WS_WUKV + (size_t)2 * D * 512 * 2);
constexpr size_t WS_WW1   = al256(WS_WOUT + (size_t)4 * D * D * 2);
constexpr size_t WS_WW2   = al256(WS_WW1 + (size_t)4 * HID * D * 2);
constexpr size_t WS_QM    = al256(WS_WW2 + (size_t)4 * D * HID * 2);
constexpr size_t WS_KM    = al256(WS_QM + (size_t)MTOT * 1536 * 2);
constexpr size_t WS_VM    = al256(WS_KM + (size_t)MTOT * 1536 * 2);
constexpr size_t WS_QN    = al256(WS_VM + (size_t)MTOT * 1024 * 2);
constexpr size_t WS_KN    = al256(WS_QN + (size_t)MTOT * 1024 * 2);
constexpr size_t WS_VN    = al256(WS_KN + (size_t)MTOT * 1024 * 2);
constexpr size_t WS_KF    = al256(WS_VN + (size_t)MTOT * 1024 * 2);
constexpr size_t WS_CKV   = al256(WS_KF + (size_t)2 * 1024 * 4096 * 8);
constexpr size_t WS_KPE   = al256(WS_CKV + (size_t)MTOT * 512 * 2);
constexpr size_t WS_HQ    = al256(WS_KPE + (size_t)MTOT * 256 * 2);
constexpr size_t WS_HU    = al256(WS_HQ + (size_t)64 * 36 * 64 * 128 * 2);
constexpr size_t WS_HE    = al256(WS_HU + (size_t)64 * 36 * 128 * 128 * 2);
constexpr size_t WS_SSQ   = al256(WS_HE + (size_t)64 * 36 * 3 * 128 * 4);
constexpr size_t WS_END   = al256(WS_SSQ + (size_t)MTOT * 8 * 4);
static_assert(WS_END <= (size_t)4 * DEPTH * D * 6 * D * 4, "workspace layout exceeds the guaranteed 4 x largest-input size");

constexpr int LDS_BYTES = 152 * 1024;
constexpr int LDS_BARW_OFF = LDS_BYTES - 16;

__device__ __forceinline__ int tid_opaque() { int t = threadIdx.x; asm volatile("" : "+v"(t)); return t; }
__device__ __forceinline__ float silu_f(float x) { return x / (1.0f + __expf(-x)); }
__device__ __forceinline__ float sigmoid_f(float x) { return 1.0f / (1.0f + __expf(-x)); }
__device__ __forceinline__ float wave_sum(float v) {
#pragma unroll
    for (int o = 32; o >= 1; o >>= 1) v += __shfl_xor(v, o);
    return v;
}
__device__ __forceinline__ int mod_row(int r) { return r < MLAT ? (r >> 11) : 4; }
typedef __bf16 bf16x2_v __attribute__((ext_vector_type(2)));
typedef float f32x2_v __attribute__((ext_vector_type(2)));
__device__ __forceinline__ unsigned cvt_pk_bf16(float lo, float hi) { const f32x2_v v = {lo, hi}; const bf16x2_v r = __builtin_convertvector(v, bf16x2_v); return __builtin_bit_cast(unsigned, r); }
__device__ __forceinline__ float bf2f(bf16_t x) { return __uint_as_float((unsigned)x << 16); }
__device__ __forceinline__ float bflo(unsigned w) { return __uint_as_float(w << 16); }
__device__ __forceinline__ float bfhi(unsigned w) { return __uint_as_float(w & 0xffff0000u); }
__device__ __forceinline__ bf16_t f2bf(float f) { return (bf16_t)(cvt_pk_bf16(f, 0.f) & 0xffffu); }

__device__ __forceinline__ void phase_adaln(KP P, float* lds, int l, int cu, int ncu) {
    const int tid = tid_opaque();
    float* sv = lds;
    float* red = lds + 5 * D;
    __syncthreads();
    for (int i = tid; i < 5 * D; i += NTHR) {
        const int r = i / D, k = i % D;
        const float v = r < 4 ? P->c[r * D + k] : P->c_ctx[k];
        sv[i] = silu_f(v);
    }
    __syncthreads();
    const int ng = tid & 15, ks = tid >> 4;
    for (int unit = cu; unit < 192; unit += ncu) {
        const int n0 = unit * 64;
        float acc[5][4];
#pragma unroll
        for (int r = 0; r < 5; ++r)
#pragma unroll
            for (int j = 0; j < 4; ++j) acc[r][j] = 0.f;
        const float* wp = P->ada_w + ((size_t)l * D + ks * 64) * (6 * D) + n0 + ng * 4;
#pragma unroll 16
        for (int k = 0; k < 64; ++k) {
            const float4 w4 = *(const float4*)(wp + (size_t)k * (6 * D));
#pragma unroll
            for (int r = 0; r < 5; ++r) {
                const float s2 = sv[r * D + ks * 64 + k];
                acc[r][0] += s2 * w4.x; acc[r][1] += s2 * w4.y; acc[r][2] += s2 * w4.z; acc[r][3] += s2 * w4.w;
            }
        }
#pragma unroll
        for (int r = 0; r < 5; ++r)
#pragma unroll
            for (int j = 0; j < 4; ++j) red[(ks * 5 + r) * 64 + ng * 4 + j] = acc[r][j];
        __syncthreads();
        if (tid < 320) {
            const int r = tid >> 6, n = tid & 63;
            float s2 = 0.f;
            for (int k2 = 0; k2 < 32; ++k2) s2 += red[(k2 * 5 + r) * 64 + n];
            P->mod[((size_t)l * 5 + r) * (6 * D) + n0 + n] = s2 + P->ada_b[l * 6 * D + n0 + n];
        }
        __syncthreads();
    }
}

__device__ __forceinline__ void phase_prologue(KP P, float* lds) {
    const int tid = tid_opaque(), nb = gridDim.x, bid = blockIdx.x;
    {
        const float4* sx = (const float4*)P->x; float4* dh = (float4*)P->h;
        const size_t n4 = (size_t)MLAT * D / 4;
        for (size_t i = (size_t)bid * NTHR + tid; i < n4; i += (size_t)nb * NTHR) dh[i] = sx[i];
        const float4* sc = (const float4*)P->ctx; float4* dc = (float4*)(P->h + (size_t)MLAT * D);
        const size_t m4 = (size_t)MCTX * D / 4;
        for (size_t i = (size_t)bid * NTHR + tid; i < m4; i += (size_t)nb * NTHR) dc[i] = sc[i];
    }
    if (bid == 0) {
        for (int i = tid; i < 1024; i += NTHR) {
            const int pos = i >> 4, fi = i & 15;
            const float inv = powf(10000.0f, -(float)fi / 16.0f);
            const float ang = (float)pos * inv;
            P->rope[2 * i] = cosf(ang); P->rope[2 * i + 1] = sinf(ang);
        }
    }
    if (bid == 1 % nb) {
        for (int i = tid; i < 2 * 1024; i += NTHR) {
            const int dir = i >> 10, c = i & 1023;
            const float l0 = P->lb_logits[(dir * 2 + 0) * 1024 + c], l1 = P->lb_logits[(dir * 2 + 1) * 1024 + c];
            const float mx = fmaxf(l0, l1), e0 = expf(l0 - mx), e1 = expf(l1 - mx);
            const float p1 = e1 / (e0 + e1);
            P->lb[(dir * 2 + 0) * 1024 + c] = 0.0f;
            P->lb[(dir * 2 + 1) * 1024 + c] = p1;
        }
    }
    phase_adaln(P, lds, 0, bid, nb);
    {
        float* zv = lds;
        float* h1 = lds + 8 * 33;
        float* h2 = h1 + 8 * 64;
        float* h3 = h2 + 8 * 64;
        constexpr int NBL = SEQ / 8, NBC = CTXL / 8, NU = 2 * (NBL + NBC);
        const int pl = tid >> 6, j = tid & 63;
        for (int unit = bid; unit < NU; unit += nb) {
            const int o = unit / (NBL + NBC); const int rem = unit % (NBL + NBC);
            const bool isl = rem < NBL; const int n = isl ? SEQ : CTXL; const int pos0 = (isl ? rem : rem - NBL) * 8;
            __syncthreads();
            if (tid < 8 * 33) {
                const int p2 = tid / 33, i = tid % 33; const int pos = pos0 + p2;
                float v;
                if (i == 0) v = (float)pos / (float)(n - 1);
                else {
                    const int bi = (i - 1) & 15;
                    const float band = 1e-4f + (float)bi * ((15.0f - 1e-4f) / 15.0f);
                    const float ang = (float)(2.0 * 3.14159265358979323846 / (double)n) * (float)pos * band;
                    v = (i <= 16) ? cosf(ang) : -sinf(ang);
                }
                zv[p2 * 33 + i] = v;
            }
            __syncthreads();
            const float fr = P->ffreq[o * 64 + j];
            { float s = P->fb1[o * 64 + j];
              for (int i = 0; i < 33; ++i) s += zv[pl * 33 + i] * P->fw1[(o * 33 + i) * 64 + j];
              h1[pl * 64 + j] = sinf(fr * s); }
            __syncthreads();
            { float s = P->fb2[o * 64 + j];
#pragma unroll 8
              for (int i = 0; i < 64; ++i) s += h1[pl * 64 + i] * P->fw2[(o * 64 + i) * 64 + j];
              h2[pl * 64 + j] = sinf(fr * s); }
            __syncthreads();
            { float s = P->fb3[o * 64 + j];
#pragma unroll 8
              for (int i = 0; i < 64; ++i) s += h2[pl * 64 + i] * P->fw3[(o * 64 + i) * 64 + j];
              h3[pl * 64 + j] = sinf(fr * s); }
            __syncthreads();
            float acc[4][8];
#pragma unroll
            for (int q = 0; q < 4; ++q)
#pragma unroll
                for (int p2 = 0; p2 < 8; ++p2) acc[q][p2] = 0.f;
#pragma unroll 2
            for (int i = 0; i < 64; ++i) {
                float wv[4];
#pragma unroll
                for (int q = 0; q < 4; ++q) wv[q] = P->fwout[(o * 64 + i) * 2048 + tid + q * NTHR];
#pragma unroll
                for (int p2 = 0; p2 < 8; ++p2) { const float hv = h3[p2 * 64 + i];
#pragma unroll
                    for (int q = 0; q < 4; ++q) acc[q][p2] += hv * wv[q]; }
            }
#pragma unroll
            for (int q = 0; q < 4; ++q) {
                const int nn = tid + q * NTHR, dirn = nn >> 10, ch = nn & 1023;
                const float delta = 3.0701134573253944f + (float)ch * ((15.350567286626972f - 3.0701134573253944f) / 1023.0f);
#pragma unroll
                for (int p2 = 0; p2 < 8; ++p2) {
                    const int pos = pos0 + p2; const float t = (float)pos / (float)(n - 1);
                    float* dst = isl ? P->filt_lat + (((size_t)o * 2 + dirn) * SEQ + pos) * 1024 + ch
                                     : P->filt_ctx + (((size_t)o * 2 + dirn) * CTXL + pos) * 1024 + ch;
                    *dst = acc[q][p2] * expf(-t * delta);
                }
            }
        }
    }
}

__device__ __forceinline__ void phase_norm(KP P, int l, int which, int M, bool fold, bool zero_ssq) {
    const int tid = tid_opaque(), lane = tid & 63, w = tid >> 6;
    (void)zero_ssq;
    const float* g = (which == 0 ? P->norm_mix_g : P->norm_mlp_g) + l * D;
    for (int row = blockIdx.x * 8 + w; row < M; row += gridDim.x * 8) {
        float* hr = P->h + (size_t)row * D;
        float4 v[8]; float ss = 0.f;
#pragma unroll
        for (int i = 0; i < 8; ++i) v[i] = *(const float4*)(hr + i * 256 + lane * 4);
        if (fold && row >= MLAT) {
            const float* sl = P->kv + (size_t)(row - MLAT) * D;
#pragma unroll
            for (int ks = 0; ks < 8; ++ks)
#pragma unroll
                for (int i = 0; i < 8; ++i) { const float4 a = *(const float4*)(sl + (size_t)ks * MCTX * D + i * 256 + lane * 4); v[i].x += a.x; v[i].y += a.y; v[i].z += a.z; v[i].w += a.w; }
#pragma unroll
            for (int i = 0; i < 8; ++i) *(float4*)(hr + i * 256 + lane * 4) = v[i];
        }
#pragma unroll
        for (int i = 0; i < 8; ++i) ss += v[i].x * v[i].x + v[i].y * v[i].y + v[i].z * v[i].z + v[i].w * v[i].w;
        ss = wave_sum(ss);
        const float rstd = rsqrtf(ss * (1.0f / D) + NORM_EPS);
        const float* mr = P->mod + ((size_t)l * 5 + mod_row(row)) * (6 * D) + (which == 0 ? 0 : 3 * D);
        bf16_t* ar = P->a + (size_t)row * D;
#pragma unroll
        for (int i = 0; i < 8; ++i) {
            const int col = i * 256 + lane * 4;
            const float4 gg = *(const float4*)(g + col), sh = *(const float4*)(mr + col), sc = *(const float4*)(mr + D + col);
            float4 o;
            o.x = v[i].x * rstd * gg.x * (1.0f + sc.x) + sh.x;
            o.y = v[i].y * rstd * gg.y * (1.0f + sc.y) + sh.y;
            o.z = v[i].z * rstd * gg.z * (1.0f + sc.z) + sh.z;
            o.w = v[i].w * rstd * gg.w * (1.0f + sc.w) + sh.w;
            uint2 pk; pk.x = cvt_pk_bf16(o.x, o.y); pk.y = cvt_pk_bf16(o.z, o.w);
            *(uint2*)(ar + col) = pk;
        }
    }
}

namespace pg8 {
#define PG8_LAS __attribute__((address_space(3)))
typedef short bf16x8 __attribute__((ext_vector_type(8)));
typedef float f32x4 __attribute__((ext_vector_type(4)));
typedef unsigned u32x4 __attribute__((ext_vector_type(4)));
constexpr int BM = 256, BK = 64, HALF = 128, HTB = HALF * BK * 2, STAGE_BYTES = 8 * HTB, NXCD = 8, WGM = 8;
__host__ __device__ __forceinline__ int lds_byte(int r, int c) { const int st = (r >> 4) * 2 + (c >> 5), rr = r & 15, cc = c & 31, ob = rr * 64 + cc * 2; return st * 1024 + (ob ^ (((ob >> 9) & 1) << 5)); }
__host__ __device__ __forceinline__ void stage_rc(int b, int& R, int& C) { const int st = b / 1024, sb = b % 1024, swz = sb ^ (((sb >> 9) & 1) << 5); R = (st >> 1) * 16 + swz / 64; C = (st & 1) * 32 + (swz % 64) / 2; }
__host__ __device__ __forceinline__ int perm32(int rho) { const int n = rho >> 4, i = rho & 15; return 8 * (i >> 2) + 4 * n + (i & 3); }
struct Unit { int pm, pn, k0, nk, atomic; };
struct Gemm { const bf16_t* A; const bf16_t* Bt; int M, N, K; };
struct StaticOrder {
    int nM, nN, nwg, G, c, ntk;
    __host__ __device__ void init(int M, int N, int K, int G_, int c_) { nM = M / BM; nN = N / BM; nwg = nM * nN; G = G_; c = c_; ntk = K / BK; }
    __host__ __device__ bool next(int i, Unit& u) const {
        const long L = (long)i * G + c; if (L >= nwg) return false;
        int wgid = (int)L; { const int q = nwg / NXCD, r = nwg % NXCD, xcd = wgid % NXCD, off = wgid / NXCD; wgid = (xcd < r ? xcd * (q + 1) : r * (q + 1) + (xcd - r) * q) + off; }
        const int nig = WGM * nN, gid = wgid / nig, fm = gid * WGM, gsz = (nM - fm) < WGM ? (nM - fm) : WGM;
        u.pm = fm + ((wgid % nig) % gsz); u.pn = (wgid % nig) / gsz; u.k0 = 0; u.nk = ntk; u.atomic = 0; return true;
    }
    __device__ __forceinline__ void a_ready(const Unit&) const {}
    __device__ __forceinline__ void done(const Unit&) const {}
};
struct SplitOrder {
    StaticOrder lat; int G, c, nsub, ntk, nN;
    __host__ __device__ void init(int M, int N, int K, int G_, int c_) { lat.init(MLAT, N, K, G_, c_); G = G_; c = c_; ntk = K / BK; nN = N / BM; nsub = M > MLAT ? ((M - MLAT) / BM) * nN * 8 : 0; }
    __host__ __device__ bool next(int i, Unit& u) const {
        const long L = (long)i * G + c;
        if (L < lat.nwg) return lat.next(i, u);
        const int j = (int)(L - lat.nwg); if (j >= nsub) return false;
        const int ct = j >> 3, ks = j & 7;
        u.pm = MLAT / BM + ct / nN; u.pn = ct % nN; u.k0 = ks * (ntk / 8); u.nk = ntk / 8; u.atomic = 1; return true;
    }
    __device__ __forceinline__ void a_ready(const Unit&) const {}
    __device__ __forceinline__ void done(const Unit&) const {}
};
template <class Epi, class Sched>
__device__ __forceinline__ void gemm_phase(PG8_LAS unsigned char* lds, const Gemm g, const Sched& S, const Epi& E) {
    const int tid = tid_opaque(), wid = __builtin_amdgcn_readfirstlane(tid >> 6), lane = tid & 63, wr = wid >> 2, wc = wid & 3, fr = lane & 15, fq = lane >> 4;
    const int K = g.K;
    unsigned voffA[2], voffB[2];
#pragma unroll
    for (int i = 0; i < 2; ++i) { int R, C; stage_rc(tid * 16 + i * 8192, R, C); const int Rb = Epi::PERM ? ((R & ~31) + perm32(R & 31)) : R;
        voffA[i] = (unsigned)(R * K + C) * 2u; voffB[i] = (unsigned)(Rb * K + C) * 2u; }
    const size_t kstep = (size_t)(BK * 2);
    const size_t hstep = (size_t)HALF * K * 2;
    const size_t tstep = 2 * hstep;
    const unsigned ldsw = (unsigned)wid * 1024u;
    const int aoff = lds_byte(wr * 64 + fr, fq * 8), boff = lds_byte(wc * 32 + fr, fq * 8);
#define PG8_SA(b, h) (((b) * 2 + (h)) * HTB)
#define PG8_SB(b, h) ((4 + (b) * 2 + (h)) * HTB)
#define PG8_STAGE(bufoff, gbase, voff) do { _Pragma("unroll") for (int _i = 0; _i < 2; ++_i) \
        __builtin_amdgcn_global_load_lds((const unsigned*)((const char*)(gbase) + (voff)[_i]), (PG8_LAS unsigned*)(lds + (bufoff) + ldsw + _i * 8192), 16, 0, 0); } while (0)
#define PG8_LDA(dst, b, h) do { _Pragma("unroll") for (int m = 0; m < 4; ++m) _Pragma("unroll") for (int k = 0; k < 2; ++k) dst[m][k] = *(const PG8_LAS bf16x8*)(lds + PG8_SA(b, h) + aoff + m * 2048 + k * 1024); } while (0)
#define PG8_LDB(dst, b, h) do { _Pragma("unroll") for (int n = 0; n < 2; ++n) _Pragma("unroll") for (int k = 0; k < 2; ++k) dst[n][k] = *(const PG8_LAS bf16x8*)(lds + PG8_SB(b, h) + boff + n * 2048 + k * 1024); } while (0)
#define PG8_MMA(ai, bj, At, Bt) do { __builtin_amdgcn_s_setprio(1); _Pragma("unroll") for (int m = 0; m < 4; ++m) _Pragma("unroll") for (int n = 0; n < 2; ++n) _Pragma("unroll") for (int k = 0; k < 2; ++k) \
        acc[ai][bj][m][n] = __builtin_amdgcn_mfma_f32_16x16x32_bf16(Bt[n][k], At[m][k], acc[ai][bj][m][n], 0, 0, 0); __builtin_amdgcn_s_setprio(0); } while (0)
#define PG8_WAIT_V(n) asm volatile("s_waitcnt vmcnt(" #n ")" ::: "memory")
#define PG8_WAIT_L(n) asm volatile("s_waitcnt lgkmcnt(" #n ")" ::: "memory")
#define PG8_BAR __builtin_amdgcn_s_barrier()
#define PG8_SCHED __builtin_amdgcn_sched_barrier(0)
    Unit cur, nxt; int ui = 0;
    if (!S.next(0, cur)) return;
    f32x4 acc[2][2][4][2];
#pragma unroll
    for (int a = 0; a < 2; ++a)
#pragma unroll
        for (int b = 0; b < 2; ++b)
#pragma unroll
            for (int m = 0; m < 4; ++m)
#pragma unroll
                for (int n = 0; n < 2; ++n) acc[a][b][m][n] = (f32x4){0.f, 0.f, 0.f, 0.f};
    bf16x8 At[4][2], B0[2][2], B1[2][2];
    const char* cA = (const char*)g.A + (size_t)cur.pm * tstep + (size_t)cur.k0 * kstep; const char* cB = (const char*)g.Bt + (size_t)cur.pn * tstep + (size_t)cur.k0 * kstep;
    S.a_ready(cur);
    PG8_STAGE(PG8_SB(0, 0), cB, voffB); PG8_STAGE(PG8_SA(0, 0), cA, voffA); PG8_STAGE(PG8_SB(0, 1), cB + hstep, voffB); PG8_STAGE(PG8_SA(0, 1), cA + hstep, voffA);
    if (wr == 1) PG8_BAR;
    PG8_WAIT_V(4); PG8_BAR;
    PG8_STAGE(PG8_SB(1, 0), cB + kstep, voffB); PG8_STAGE(PG8_SA(1, 0), cA + kstep, voffA); PG8_STAGE(PG8_SB(1, 1), cB + hstep + kstep, voffB);
    PG8_WAIT_V(6); PG8_BAR;
    for (;;) {
        const bool has_next = S.next(ui + 1, nxt);
        const char* nA = has_next ? (const char*)g.A + (size_t)nxt.pm * tstep + (size_t)nxt.k0 * kstep : cA; const char* nB = has_next ? (const char*)g.Bt + (size_t)nxt.pn * tstep + (size_t)nxt.k0 * kstep : cB;
        const int nt = cur.nk;
        for (int t = 0; t < nt; t += 2) {
            const bool last = (t == nt - 2);
            const char* a1 = cA + (size_t)(t + 1) * kstep;
            const char* a2 = last ? nA : cA + (size_t)(t + 2) * kstep; const char* b2 = last ? nB : cB + (size_t)(t + 2) * kstep;
            const char* a3 = a2 + kstep; const char* b3 = b2 + kstep;
            if (last && has_next) S.a_ready(nxt);
            PG8_LDB(B0, 0, 0); PG8_SCHED; PG8_LDA(At, 0, 0); PG8_STAGE(PG8_SA(1, 1), a1 + hstep, voffA);
            PG8_WAIT_L(8); PG8_BAR; PG8_WAIT_L(0); PG8_MMA(0, 0, At, B0); PG8_BAR; PG8_SCHED;
            PG8_LDB(B1, 0, 1); PG8_STAGE(PG8_SB(0, 0), b2, voffB);
            PG8_BAR; PG8_WAIT_L(0); PG8_MMA(0, 1, At, B1); PG8_BAR;
            PG8_LDA(At, 0, 1); PG8_STAGE(PG8_SA(0, 0), a2, voffA);
            PG8_BAR; PG8_WAIT_L(0); PG8_MMA(1, 0, At, B0); PG8_BAR; PG8_SCHED;
            PG8_STAGE(PG8_SB(0, 1), b2 + hstep, voffB);
            PG8_WAIT_V(6); PG8_BAR; PG8_MMA(1, 1, At, B1); PG8_BAR;
            PG8_LDB(B0, 1, 0); PG8_SCHED; PG8_LDA(At, 1, 0); PG8_STAGE(PG8_SA(0, 1), a2 + hstep, voffA);
            PG8_WAIT_L(8); PG8_BAR; PG8_WAIT_L(0); PG8_MMA(0, 0, At, B0); PG8_BAR; PG8_SCHED;
            PG8_LDB(B1, 1, 1); PG8_STAGE(PG8_SB(1, 0), b3, voffB);
            PG8_BAR; PG8_WAIT_L(0); PG8_MMA(0, 1, At, B1); PG8_BAR;
            PG8_LDA(At, 1, 1); PG8_STAGE(PG8_SA(1, 0), a3, voffA);
            PG8_BAR; PG8_WAIT_L(0); PG8_MMA(1, 0, At, B0); PG8_BAR; PG8_SCHED;
            PG8_STAGE(PG8_SB(1, 1), b3 + hstep, voffB);
            PG8_WAIT_V(6); PG8_BAR; PG8_MMA(1, 1, At, B1); PG8_BAR;
        }
        E(acc, cur, wr, wc, fr, fq); S.done(cur);
        if (!has_next) break;
#pragma unroll
        for (int a = 0; a < 2; ++a)
#pragma unroll
            for (int b = 0; b < 2; ++b)
#pragma unroll
                for (int m = 0; m < 4; ++m)
#pragma unroll
                    for (int n = 0; n < 2; ++n) acc[a][b][m][n] = (f32x4){0.f, 0.f, 0.f, 0.f};
        cur = nxt; cA = nA; cB = nB; ++ui;
    }
    PG8_WAIT_V(0);
    if (wr == 0) PG8_BAR;
    PG8_BAR;
#undef PG8_SA
#undef PG8_SB
#undef PG8_STAGE
#undef PG8_LDA
#undef PG8_LDB
#undef PG8_MMA
#undef PG8_WAIT_V
#undef PG8_WAIT_L
#undef PG8_BAR
#undef PG8_SCHED
}
}

struct EpiStoreF32 {
    static constexpr bool PERM = false;
    float* C; int ldc;
    __device__ __forceinline__ void operator()(const pg8::f32x4 (&acc)[2][2][4][2], const pg8::Unit& u, int wr, int wc, int fr, int fq) const {
        const int row0 = u.pm * 256 + wr * 64 + fr, col0 = u.pn * 256 + wc * 32 + 4 * fq;
#pragma unroll
        for (int ai = 0; ai < 2; ++ai)
#pragma unroll
            for (int m = 0; m < 4; ++m) { float* rowp = C + (size_t)(row0 + ai * 128 + m * 16) * ldc + col0;
#pragma unroll
                for (int bj = 0; bj < 2; ++bj)
#pragma unroll
                    for (int n = 0; n < 2; ++n) *(pg8::f32x4*)(rowp + bj * 128 + n * 16) = acc[ai][bj][m][n]; }
    }
};
struct EpiResid {
    static constexpr bool PERM = false;
    float* h; const float* gate; float* slab;
    __device__ __forceinline__ void operator()(const pg8::f32x4 (&acc)[2][2][4][2], const pg8::Unit& u, int wr, int wc, int fr, int fq) const {
        const int row0 = u.pm * 256 + wr * 64 + fr, col0 = u.pn * 256 + wc * 32 + 4 * fq;
#pragma unroll
        for (int ai = 0; ai < 2; ++ai)
#pragma unroll
            for (int m = 0; m < 4; ++m) { const int row = row0 + ai * 128 + m * 16; float* rowp = h + (size_t)row * D + col0; const float* gp = gate + (size_t)mod_row(row) * (6 * D) + col0;
#pragma unroll
                for (int bj = 0; bj < 2; ++bj)
#pragma unroll
                    for (int n = 0; n < 2; ++n) { const pg8::f32x4 gt = *(const pg8::f32x4*)(gp + bj * 128 + n * 16); const pg8::f32x4 v = gt * acc[ai][bj][m][n]; float* q = rowp + bj * 128 + n * 16;
                        if (u.atomic) { *(pg8::f32x4*)(slab + ((size_t)(u.k0 / u.nk) * MCTX + (row - MLAT)) * D + col0 + bj * 128 + n * 16) = v; }
                        else { const pg8::f32x4 hv = *(const pg8::f32x4*)q; *(pg8::f32x4*)q = hv + v; } } }
    }
};
struct EpiRelu2Bf16 {
    static constexpr bool PERM = true;
    bf16_t* O; int ldc;
    __device__ __forceinline__ void operator()(const pg8::f32x4 (&acc)[2][2][4][2], const pg8::Unit& u, int wr, int wc, int fr, int fq) const {
        const int row0 = u.pm * 256 + wr * 64 + fr, col0 = u.pn * 256 + wc * 32 + 8 * fq;
#pragma unroll
        for (int ai = 0; ai < 2; ++ai)
#pragma unroll
            for (int m = 0; m < 4; ++m) { bf16_t* rowp = O + (size_t)(row0 + ai * 128 + m * 16) * ldc + col0;
#pragma unroll
                for (int bj = 0; bj < 2; ++bj) { pg8::f32x4 v0 = acc[ai][bj][m][0], v1 = acc[ai][bj][m][1];
#pragma unroll
                    for (int j = 0; j < 4; ++j) { const float a0 = fmaxf(v0[j], 0.f), a1 = fmaxf(v1[j], 0.f); v0[j] = a0 * a0; v1[j] = a1 * a1; }
                    pg8::u32x4 w; w.x = cvt_pk_bf16(v0[0], v0[1]); w.y = cvt_pk_bf16(v0[2], v0[3]); w.z = cvt_pk_bf16(v1[0], v1[1]); w.w = cvt_pk_bf16(v1[2], v1[3]);
                    *(pg8::u32x4*)(rowp + bj * 128) = w; } }
    }
};
template <class F> __device__ __forceinline__ void epi_bf16_rows(const pg8::f32x4 (&acc)[2][2][4][2], int row0, const F& dst) {
#pragma unroll
    for (int ai = 0; ai < 2; ++ai)
#pragma unroll
        for (int m = 0; m < 4; ++m) { const int row = row0 + ai * 128 + m * 16;
#pragma unroll
            for (int bj = 0; bj < 2; ++bj) { const pg8::f32x4 v0 = acc[ai][bj][m][0], v1 = acc[ai][bj][m][1];
                pg8::u32x4 w; w.x = cvt_pk_bf16(v0[0], v0[1]); w.y = cvt_pk_bf16(v0[2], v0[3]); w.z = cvt_pk_bf16(v1[0], v1[1]); w.w = cvt_pk_bf16(v1[2], v1[3]);
                *(pg8::u32x4*)dst(row, bj) = w; } }
}
struct EpiStoreBf16 {
    static constexpr bool PERM = true;
    bf16_t* O; int ldc;
    __device__ __forceinline__ void operator()(const pg8::f32x4 (&acc)[2][2][4][2], const pg8::Unit& u, int wr, int wc, int fr, int fq) const {
        const int col0 = u.pn * 256 + wc * 32 + 8 * fq; bf16_t* O_ = O; const int ldc_ = ldc;
        epi_bf16_rows(acc, u.pm * 256 + wr * 64 + fr, [=](int row, int bj) { return O_ + (size_t)row * ldc_ + col0 + bj * 128; });
    }
};
struct EpiEvenRoute {
    static constexpr bool PERM = true;
    bf16_t *qm, *ckv, *qn, *kn, *vn, *kpe; float* ssq;
    __device__ __forceinline__ void operator()(const pg8::f32x4 (&acc)[2][2][4][2], const pg8::Unit& u, int wr, int wc, int fr, int fq) const {
        const int pn = u.pn; bf16_t* base; int ldc, colt;
        if (pn < 6) { base = qm; ldc = 1536; colt = pn * 256; } else if (pn < 8) { base = ckv; ldc = 512; colt = (pn - 6) * 256; }
        else if (pn < 12) { base = qn; ldc = 1024; colt = (pn - 8) * 256; } else if (pn < 16) { base = kn; ldc = 1024; colt = (pn - 12) * 256; }
        else if (pn < 20) { base = vn; ldc = 1024; colt = (pn - 16) * 256; } else { base = kpe; ldc = 256; colt = 0; }
        const int col0 = colt + wc * 32 + 8 * fq;
        epi_bf16_rows(acc, u.pm * 256 + wr * 64 + fr, [=](int row, int bj) { return base + (size_t)row * ldc + col0 + bj * 128; });
        if (pn == 6 || pn == 7) {
#pragma unroll
            for (int ai = 0; ai < 2; ++ai)
#pragma unroll
                for (int m = 0; m < 4; ++m) { float q = 0.f;
#pragma unroll
                    for (int bj = 0; bj < 2; ++bj)
#pragma unroll
                        for (int n = 0; n < 2; ++n) { const pg8::f32x4 x = acc[ai][bj][m][n]; q += (x[0] * x[0] + x[1] * x[1]) + (x[2] * x[2] + x[3] * x[3]); }
                    q += __shfl_xor(q, 16); q += __shfl_xor(q, 32);
                    if (fq == 0) ssq[(size_t)(u.pm * 256 + wr * 64 + fr + ai * 128 + m * 16) * 8 + (pn - 6) * 4 + wc] = q; }
        }
    }
};
struct EpiKV {
    static constexpr bool PERM = true;
    bf16_t *km, *vm; const float* ssq;
    __device__ __forceinline__ void operator()(const pg8::f32x4 (&acc)[2][2][4][2], const pg8::Unit& u, int wr, int wc, int fr, int fq) const {
        const int cw = wc * 32 + 8 * fq, row0 = u.pm * 256 + wr * 64 + fr; bf16_t* kb = km + u.pn * 192 + cw; bf16_t* vb = vm + u.pn * 128 + cw;
#pragma unroll
        for (int ai = 0; ai < 2; ++ai)
#pragma unroll
            for (int m = 0; m < 4; ++m) { const int row = row0 + ai * 128 + m * 16; const pg8::f32x4 sa = *(const pg8::f32x4*)(ssq + (size_t)row * 8), sb = *(const pg8::f32x4*)(ssq + (size_t)row * 8 + 4);
                const float rs = rsqrtf((((sa[0] + sa[1]) + (sa[2] + sa[3])) + ((sb[0] + sb[1]) + (sb[2] + sb[3]))) * (1.0f / 512.0f) + NORM_EPS);
#pragma unroll
                for (int bj = 0; bj < 2; ++bj) { const pg8::f32x4 v0 = acc[ai][bj][m][0] * rs, v1 = acc[ai][bj][m][1] * rs;
                    pg8::u32x4 w; w.x = cvt_pk_bf16(v0[0], v0[1]); w.y = cvt_pk_bf16(v0[2], v0[3]); w.z = cvt_pk_bf16(v1[0], v1[1]); w.w = cvt_pk_bf16(v1[2], v1[3]);
                    *(pg8::u32x4*)(bj == 0 ? kb + (size_t)row * 1536 : vb + (size_t)row * 1024) = w; } }
    }
};
template <class Epi> __device__ __forceinline__ void run_gemm(LAS unsigned char* lds, const bf16_t* A, const bf16_t* Bt, int M, int N, int K, const Epi& E) {
    pg8::Gemm g{A, Bt, M, N, K}; pg8::StaticOrder S; S.init(M, N, K, (int)gridDim.x, (int)blockIdx.x);
    pg8::gemm_phase<Epi, pg8::StaticOrder>(lds, g, S, E);
}
template <class Epi> __device__ __forceinline__ void run_gemm_split(LAS unsigned char* lds, const bf16_t* A, const bf16_t* Bt, int M, int N, int K, const Epi& E) {
    pg8::Gemm g{A, Bt, M, N, K}; pg8::SplitOrder S; S.init(M, N, K, (int)gridDim.x, (int)blockIdx.x);
    pg8::gemm_phase<Epi, pg8::SplitOrder>(lds, g, S, E);
}

struct WtTile { const float* W; bf16_t* Wt; const float* rs; int K, N, k0, n0, ns; };
__device__ __forceinline__ WtTile wt_tile(KP P, int unit) {
    WtTile r; int t; r.rs = nullptr;
    if (unit < 1344)      { const int j = unit / 672;          t = unit % 672;           r.W = P->ev_w_in + (size_t)j * D * EVW; r.Wt = P->wt_ev + (size_t)j * EVP * D; r.K = D; r.N = EVW; }
    else if (unit < 3392) { const int j = (unit - 1344) / 1024; t = (unit - 1344) % 1024; r.W = P->od_w_in + (size_t)j * D * ODW; r.Wt = P->wt_od + (size_t)j * ODW * D; r.K = D; r.N = ODW; }
    else if (unit < 3520) { const int j = (unit - 3392) / 64;   t = (unit - 3392) % 64;   r.W = P->w_ukv + (size_t)j * 512 * D;   r.Wt = P->wt_ukv + (size_t)j * D * 512;  r.K = 512; r.N = D; r.rs = P->kv_norm_g + j * 512; }
    else if (unit < 4544) { const int j = (unit - 3520) / 256;  t = (unit - 3520) % 256;  r.W = P->w_out + (size_t)j * D * D;     r.Wt = P->wt_out + (size_t)j * D * D;    r.K = D; r.N = D; }
    else if (unit < 8640) { const int j = (unit - 4544) / 1024; t = (unit - 4544) % 1024; r.W = P->mlp_w1 + (size_t)j * D * HID;  r.Wt = P->wt_w1 + (size_t)j * HID * D;   r.K = D; r.N = HID; }
    else                  { const int j = (unit - 8640) / 1024; t = (unit - 8640) % 1024; r.W = P->mlp_w2 + (size_t)j * HID * D;  r.Wt = P->wt_w2 + (size_t)j * D * HID;   r.K = HID; r.N = D; }
    const int nkt = r.K / 256; r.k0 = (t % nkt) * 256; r.n0 = (t / nkt) * 64;
    r.ns = r.n0; if (unit < 1344) r.ns = r.n0 < 2048 ? r.n0 : (r.n0 < 5120 ? r.n0 + 64 : (r.n0 < 5184 ? r.n0 - 5120 + 2048 : r.N));
    return r;
}
template <int MODE> __device__ __forceinline__ void phase_convert_weights(KP P, float* ldsf, int cu, int ncu) {
    unsigned* T = (unsigned*)ldsf;
    const int tid = tid_opaque();
    constexpr int NTILES = MODE == 0 ? 12736 - 1280 : (MODE == 1 ? 256 : 1024);
#define WT_MAP(j_) (MODE == 0 ? ((j_) < 4032 ? (j_) : ((j_) < 4032 + 2304 ? (j_) + 256 : (j_) + 1280)) : (MODE == 1 ? 4032 + (j_) : 6592 + (j_)))
    float4 r0[4], r1[4];
#define WT_LOAD(u_) do { const WtTile q_ = wt_tile(P, WT_MAP(u_)); _Pragma("unroll") for (int i = 0; i < 4; ++i) { const int idx = tid + i * NTHR, c4 = idx & 15, kp = idx >> 4; \
        if (q_.ns + c4 * 4 < q_.N) { const float* src = q_.W + (size_t)(q_.k0 + 2 * kp) * q_.N + q_.ns + c4 * 4; r0[i] = *(const float4*)src; r1[i] = *(const float4*)(src + q_.N); \
            if (q_.rs) { const float g0_ = q_.rs[q_.k0 + 2 * kp], g1_ = q_.rs[q_.k0 + 2 * kp + 1]; r0[i].x *= g0_; r0[i].y *= g0_; r0[i].z *= g0_; r0[i].w *= g0_; r1[i].x *= g1_; r1[i].y *= g1_; r1[i].z *= g1_; r1[i].w *= g1_; } } \
        else { r0[i] = make_float4(0.f, 0.f, 0.f, 0.f); r1[i] = r0[i]; } } } while (0)
    int unit = cu;
    if (unit < NTILES) WT_LOAD(unit);
    for (; unit < NTILES; unit += ncu) {
        __syncthreads();
#pragma unroll
        for (int i = 0; i < 4; ++i) {
            const int idx = tid + i * NTHR, c4 = idx & 15, kp = idx >> 4;
            T[(c4 * 4 + 0) * 129 + kp] = cvt_pk_bf16(r0[i].x, r1[i].x);
            T[(c4 * 4 + 1) * 129 + kp] = cvt_pk_bf16(r0[i].y, r1[i].y);
            T[(c4 * 4 + 2) * 129 + kp] = cvt_pk_bf16(r0[i].z, r1[i].z);
            T[(c4 * 4 + 3) * 129 + kp] = cvt_pk_bf16(r0[i].w, r1[i].w);
        }
        if (unit + ncu < NTILES) WT_LOAD(unit + ncu);
        __syncthreads();
        const WtTile q = wt_tile(P, WT_MAP(unit));
#pragma unroll
        for (int i = 0; i < 4; ++i) {
            const int idx = tid + i * NTHR, kc = idx & 31, n = idx >> 5;
            uint4 w; w.x = T[n * 129 + kc * 4 + 0]; w.y = T[n * 129 + kc * 4 + 1]; w.z = T[n * 129 + kc * 4 + 2]; w.w = T[n * 129 + kc * 4 + 3];
            *(uint4*)(q.Wt + (size_t)(q.n0 + n) * q.K + q.k0 + kc * 8) = w;
        }
    }
#undef WT_LOAD
#undef WT_MAP
    __syncthreads();
}

__device__ __forceinline__ void phase_ckvnorm(KP P, int e) {
    const int tid = tid_opaque(), lane = tid & 63, w = tid >> 6;
    const float* g = P->kv_norm_g + e * 512;
    for (int row = blockIdx.x * 8 + w; row < MTOT; row += gridDim.x * 8) {
        const uint4 x = *(const uint4*)(P->ckv + (size_t)row * 512 + lane * 8);
        float v[8] = {bflo(x.x), bfhi(x.x), bflo(x.y), bfhi(x.y), bflo(x.z), bfhi(x.z), bflo(x.w), bfhi(x.w)};
        float ss = 0.f;
#pragma unroll
        for (int j = 0; j < 8; ++j) ss += v[j] * v[j];
        ss = wave_sum(ss);
        const float rstd = rsqrtf(ss * (1.0f / 512.0f) + NORM_EPS);
        const float4 g0 = *(const float4*)(g + lane * 8), g1 = *(const float4*)(g + lane * 8 + 4);
        uint4 o; o.x = cvt_pk_bf16(v[0] * rstd * g0.x, v[1] * rstd * g0.y); o.y = cvt_pk_bf16(v[2] * rstd * g0.z, v[3] * rstd * g0.w);
        o.z = cvt_pk_bf16(v[4] * rstd * g1.x, v[5] * rstd * g1.y); o.w = cvt_pk_bf16(v[6] * rstd * g1.z, v[7] * rstd * g1.w);
        *(uint4*)(P->ckvn + (size_t)row * 512 + lane * 8) = o;
    }
}
__device__ __forceinline__ void rope_pair(const bf16_t* src, int dd, int pos, const float* rope, bool lat, uint4& oa, uint4& ob) {
    const uint4 xa = *(const uint4*)(src + dd), xb = *(const uint4*)(src + dd + 16);
    if (!lat) { oa = xa; ob = xb; return; }
    const float a[8] = {bflo(xa.x), bfhi(xa.x), bflo(xa.y), bfhi(xa.y), bflo(xa.z), bfhi(xa.z), bflo(xa.w), bfhi(xa.w)};
    const float b[8] = {bflo(xb.x), bfhi(xb.x), bflo(xb.y), bfhi(xb.y), bflo(xb.z), bfhi(xb.z), bflo(xb.w), bfhi(xb.w)};
    float ra[8], rb[8]; const int i0 = dd & 15;
#pragma unroll
    for (int j = 0; j < 8; ++j) { const float cs = rope[(pos * 16 + i0 + j) * 2], sn = rope[(pos * 16 + i0 + j) * 2 + 1]; ra[j] = a[j] * cs - b[j] * sn; rb[j] = b[j] * cs + a[j] * sn; }
    oa.x = cvt_pk_bf16(ra[0], ra[1]); oa.y = cvt_pk_bf16(ra[2], ra[3]); oa.z = cvt_pk_bf16(ra[4], ra[5]); oa.w = cvt_pk_bf16(ra[6], ra[7]);
    ob.x = cvt_pk_bf16(rb[0], rb[1]); ob.y = cvt_pk_bf16(rb[2], rb[3]); ob.z = cvt_pk_bf16(rb[4], rb[5]); ob.w = cvt_pk_bf16(rb[6], rb[7]);
}
__device__ __forceinline__ void phase_rope_fix(KP P) {
    const size_t total = (size_t)MTOT * 36;
    for (size_t it = (size_t)blockIdx.x * NTHR + tid_opaque(); it < total; it += (size_t)gridDim.x * NTHR) {
        const int row = (int)(it / 36), c = (int)(it % 36);
        const bool lat = row < MLAT; const int tpos = row & (SEQ - 1), grow = tpos >> 6, gcol = tpos & 63;
        const int q4 = c & 3, dd = (q4 >> 1) * 32 + (q4 & 1) * 8, pos = (q4 >> 1) ? gcol : grow;
        uint4 oa, ob;
        if (c < 32) {
            if (!lat) continue;
            bf16_t* v = P->qm + (size_t)row * 1536 + (c >> 2) * 192 + 128;
            rope_pair(v, dd, pos, P->rope, true, oa, ob);
            *(uint4*)(v + dd) = oa; *(uint4*)(v + dd + 16) = ob;
        } else {
            rope_pair(P->kpe + (size_t)row * 256, dd, pos, P->rope, lat, oa, ob);
            bf16_t* k = P->km + (size_t)row * 1536 + 128;
#pragma unroll
            for (int hh = 0; hh < 8; ++hh) { *(uint4*)(k + hh * 192 + dd) = oa; *(uint4*)(k + hh * 192 + dd + 16) = ob; }
        }
    }
}

namespace att {
typedef short bf16x8 __attribute__((ext_vector_type(8)));
typedef short s16x4 __attribute__((ext_vector_type(4)));
typedef float f32x16 __attribute__((ext_vector_type(16)));
typedef unsigned u32x4 __attribute__((ext_vector_type(4)));
constexpr int SHM_V = 64 * 128 * 2;
#define ATT_SBAR() __builtin_amdgcn_sched_barrier(0)
__device__ __forceinline__ int crow(int r, int hi) { return (r & 3) + 8 * (r >> 2) + 4 * hi; }
__device__ __forceinline__ unsigned cvtpk(float lo, float hi) { return cvt_pk_bf16(lo, hi); }
__device__ __forceinline__ void partialSM(f32x16& p0, f32x16& p1, float& m_reg, float& mn, float& alpha, const float C, const float thr_raw) {
  float pmax = p0[0];
#pragma unroll
  for (int r = 1; r < 16; ++r) pmax = fmaxf(pmax, p0[r]);
#pragma unroll
  for (int r = 0; r < 16; ++r) pmax = fmaxf(pmax, p1[r]);
  { auto rr = __builtin_amdgcn_permlane32_swap(__float_as_uint(pmax), __float_as_uint(pmax), false, false);
    pmax = fmaxf(__uint_as_float(rr[0]), __uint_as_float(rr[1])); }
  if (__builtin_expect(__all(pmax - m_reg <= thr_raw), 1)) { mn = m_reg; alpha = 1.f; }
  else { mn = fmaxf(m_reg, pmax); alpha = __builtin_amdgcn_exp2f((m_reg - mn) * C); m_reg = mn; }
  const float mnC = -mn * C;
#pragma unroll
  for (int r = 0; r < 16; ++r) p0[r] = fmaf(p0[r], C, mnC);
#pragma unroll
  for (int r = 0; r < 16; ++r) p1[r] = fmaf(p1[r], C, mnC);
#pragma unroll
  for (int r = 0; r < 16; ++r) p0[r] = __builtin_amdgcn_exp2f(p0[r]);
}
__device__ __forceinline__ void finishSM(f32x16& p0, f32x16& p1, float alpha, float& l_reg, bf16x8& pa0, bf16x8& pa1, bf16x8& pa2, bf16x8& pa3) {
#pragma unroll
  for (int r = 0; r < 16; ++r) p1[r] = __builtin_amdgcn_exp2f(p1[r]);
  float ps = 0;
#pragma unroll
  for (int r = 0; r < 16; ++r) ps += p0[r];
#pragma unroll
  for (int r = 0; r < 16; ++r) ps += p1[r];
  { auto rr = __builtin_amdgcn_permlane32_swap(__float_as_uint(ps), __float_as_uint(ps), false, false);
    ps = __uint_as_float(rr[0]) + __uint_as_float(rr[1]); }
  l_reg = l_reg * alpha + ps;
#define ATT_PK4(P, BASE, OUT) do { unsigned a0 = cvtpk(P[BASE + 0], P[BASE + 1]), a1 = cvtpk(P[BASE + 2], P[BASE + 3]);   \
    unsigned b0 = cvtpk(P[BASE + 4], P[BASE + 5]), b1 = cvtpk(P[BASE + 6], P[BASE + 7]);                              \
    auto r0 = __builtin_amdgcn_permlane32_swap(a0, b0, false, false); auto r1 = __builtin_amdgcn_permlane32_swap(a1, b1, false, false); \
    u32x4 w = {r0[0], r1[0], r0[1], r1[1]}; OUT = *reinterpret_cast<bf16x8*>(&w); } while (0)
  ATT_PK4(p0, 0, pa0); ATT_PK4(p0, 8, pa1); ATT_PK4(p1, 0, pa2); ATT_PK4(p1, 8, pa3);
#undef ATT_PK4
}
template <int DQK> __device__ __forceinline__ int kswz(int row, int colB) { return row * (DQK == 192 ? 512 : 256) + (colB ^ ((row & 15) << 4)); }
template <int DQK> __device__ __forceinline__ void qkt(f32x16& p0, f32x16& p1, const char* Ks, const bf16x8* qr, int r32, int hi) {
  p0 = f32x16{}; p1 = f32x16{};
#pragma unroll
  for (int d0 = 0; d0 < DQK / 16; ++d0) { const int cb = (d0 * 16 + hi * 8) * 2;
    const bf16x8 b0 = *reinterpret_cast<const bf16x8*>(Ks + kswz<DQK>(r32, cb));
    const bf16x8 b1 = *reinterpret_cast<const bf16x8*>(Ks + kswz<DQK>(32 + r32, cb));
    p0 = __builtin_amdgcn_mfma_f32_32x32x16_bf16(b0, qr[d0], p0, 0, 0, 0);
    p1 = __builtin_amdgcn_mfma_f32_32x32x16_bf16(b1, qr[d0], p1, 0, 0, 0);
    if ((d0 & 3) == 3) ATT_SBAR(); }
}
__device__ __forceinline__ int v_st(int k, int c) { const int kk = (k & ~0xC) | ((k & 4) << 1) | ((k & 8) >> 1); return ((kk >> 3) * 4 + (c >> 5)) * 512 + ((kk & 7) * 32 + (c & 31)) * 2; }
__device__ __forceinline__ int v_rd_base(int lane) { return ((lane & 3) << 3) | (((lane >> 2) & 3) << 6) | (((lane >> 4) & 1) << 5) | (((lane >> 5) & 1) << 8); }
constexpr int v_rd_off(int d0, int ks, int half) { return d0 * 512 + ks * 4096 + half * 2048; }
template <int OFF> __device__ __forceinline__ s16x4 tr_read(int vb) {
  s16x4 r; asm volatile("ds_read_b64_tr_b16 %0, %1 offset:%2" : "=&v"(r) : "v"(vb), "i"(OFF) : "memory"); return r;
}
template <int D0> __device__ __forceinline__ void pv_one(f32x16& od, int vb, bf16x8 pa0, bf16x8 pa1, bf16x8 pa2, bf16x8 pa3) {
  const s16x4 l0 = tr_read<v_rd_off(D0, 0, 0)>(vb), h0 = tr_read<v_rd_off(D0, 0, 1)>(vb), l1 = tr_read<v_rd_off(D0, 1, 0)>(vb), h1 = tr_read<v_rd_off(D0, 1, 1)>(vb);
  const s16x4 l2 = tr_read<v_rd_off(D0, 2, 0)>(vb), h2 = tr_read<v_rd_off(D0, 2, 1)>(vb), l3 = tr_read<v_rd_off(D0, 3, 0)>(vb), h3 = tr_read<v_rd_off(D0, 3, 1)>(vb);
  asm volatile("s_waitcnt lgkmcnt(0)" ::: "memory"); ATT_SBAR();
#define ATT_PK(L, H) (bf16x8){L[0], L[1], L[2], L[3], H[0], H[1], H[2], H[3]}
  od = __builtin_amdgcn_mfma_f32_32x32x16_bf16(pa0, ATT_PK(l0, h0), od, 0, 0, 0);
  od = __builtin_amdgcn_mfma_f32_32x32x16_bf16(pa1, ATT_PK(l1, h1), od, 0, 0, 0);
  od = __builtin_amdgcn_mfma_f32_32x32x16_bf16(pa2, ATT_PK(l2, h2), od, 0, 0, 0);
  od = __builtin_amdgcn_mfma_f32_32x32x16_bf16(pa3, ATT_PK(l3, h3), od, 0, 0, 0);
#undef ATT_PK
}
__device__ __forceinline__ void pv_d0(f32x16* o, int vb, bf16x8 pa0, bf16x8 pa1, bf16x8 pa2, bf16x8 pa3) {
  pv_one<0>(o[0], vb, pa0, pa1, pa2, pa3); pv_one<1>(o[1], vb, pa0, pa1, pa2, pa3); pv_one<2>(o[2], vb, pa0, pa1, pa2, pa3); pv_one<3>(o[3], vb, pa0, pa1, pa2, pa3);
}
template <int HALF> __device__ __forceinline__ void na_adjust(f32x16& p, const float* bq, int tcs, float inv_scale) {
#pragma unroll
  for (int r = 0; r < 16; ++r) { constexpr int dummy = 0; (void)dummy; const int kr_ = HALF * 32 + (r & 3) + 8 * (r >> 2);
    const bool valid = (unsigned)(kr_ + tcs) < 16u; const float bv = bq[kr_]; p[r] = valid ? fmaf(bv, inv_scale, p[r]) : -1e30f; }
}
template <int DQK, bool NA>
__device__ __forceinline__ void attn_unit(const bf16_t* __restrict__ Qb, const bf16_t* __restrict__ Kc, const bf16_t* __restrict__ Kl, const bf16_t* __restrict__ Vc, const bf16_t* __restrict__ Vl,
                                          bf16_t* __restrict__ Ob, const int nct, const int NT, const int kr0, const int g0, const float* biasT, const float C, const float thr_raw, const float inv_scale,
                                          char* lds, const int tid) {
  constexpr int LDQ = DQK == 192 ? 1536 : 1024, LDK = LDQ, LDV = 1024, LDO = 2048, SHM_K = 64 * (DQK == 192 ? 512 : 256), NQ = DQK / 16, NCH = DQK / 8, KPT = DQK / 64;
  const int wid = tid >> 6, lane = tid & 63, r32 = lane & 31, hi = lane >> 5;
  char* V_lds = lds; char* K_lds = lds + 2 * SHM_V;
  float* wsw = (float*)(lds + 2 * SHM_V + 2 * SHM_K) + wid * 64; float* li_l = wsw; float* al_l = wsw + 32;
  float m_reg = -1e30f, l_reg = 0.f; f32x16 o[4] = {}; bf16x8 qr[NQ];
  const bf16_t* Qw = Qb + (size_t)(wid * 32 + r32) * LDQ + hi * 8;
#pragma unroll
  for (int d0 = 0; d0 < NQ; ++d0) qr[d0] = *reinterpret_cast<const bf16x8*>(Qw + d0 * 16);
  const int sr = tid >> 4, sc = (tid & 15) * 8, vst0 = v_st(sr, sc), vst1 = v_st(32 + sr, sc);
  const int vb0 = (int)(uintptr_t)V_lds + v_rd_base(lane);
  bf16x8 vs0, vs1, ks[KPT];
#define ATT_SLOAD(t) do { const int _t = (t); const bool _c = _t < nct; const size_t _r0 = _c ? (size_t)_t * 64 : (size_t)(NA ? (kr0 + _t - nct) : (_t - nct)) * 64; \
    const bf16_t* _K = (_c ? Kc : Kl) + _r0 * LDK; const bf16_t* _V = (_c ? Vc : Vl) + _r0 * LDV; \
    vs0 = *reinterpret_cast<const bf16x8*>(_V + (size_t)sr * LDV + sc); vs1 = *reinterpret_cast<const bf16x8*>(_V + (size_t)(32 + sr) * LDV + sc); \
    _Pragma("unroll") for (int _i = 0; _i < KPT; ++_i) { const int _id = tid + _i * NTHR, _row = _id / NCH, _c8 = _id % NCH; ks[_i] = *reinterpret_cast<const bf16x8*>(_K + (size_t)_row * LDK + _c8 * 8); } } while (0)
#define ATT_SWRITE(b) do { *(bf16x8*)(V_lds + (b) * SHM_V + vst0) = vs0; *(bf16x8*)(V_lds + (b) * SHM_V + vst1) = vs1; \
    _Pragma("unroll") for (int _i = 0; _i < KPT; ++_i) { const int _id = tid + _i * NTHR, _row = _id / NCH, _c8 = _id % NCH; *(bf16x8*)(K_lds + (b) * SHM_K + kswz<DQK>(_row, _c8 * 16)) = ks[_i]; } } while (0)
#define ATT_RESC(a) do { if (__any((a) < 1.f)) { if (hi == 0) al_l[r32] = (a); asm volatile("s_waitcnt lgkmcnt(0)" ::: "memory"); \
    _Pragma("unroll") for (int d = 0; d < 4; ++d) _Pragma("unroll") for (int r = 0; r < 16; ++r) o[d][r] *= al_l[crow(r, hi)]; } } while (0)
  const int g = g0 + (wid >> 1), qc = (wid & 1) * 32 + r32;
  int cs = qc - 8; cs = cs < 0 ? 0 : (cs > 48 ? 48 : cs);
  int rs = g - 4; rs = rs < 0 ? 0 : (rs > 24 ? 24 : rs);
  f32x16 p0, p1; float mn, al; bf16x8 pa0, pa1, pa2, pa3;
  ATT_SLOAD(0); asm volatile("s_waitcnt vmcnt(0)" ::: "memory"); ATT_SWRITE(0); __syncthreads();
#pragma nounroll
  for (int t = 0; t < NT; ++t) {
    const int buf = t & 1;
    bool active = true; int kr = 0;
    if (NA && t >= nct) { kr = kr0 + t - nct; active = (kr >= rs) && (kr < rs + 8); }
    if (active) qkt<DQK>(p0, p1, K_lds + buf * SHM_K, qr, r32, hi);
    ATT_SBAR();
    if (t + 1 < NT) ATT_SLOAD(t + 1);
    ATT_SBAR();
    if (active) {
      if (NA && t >= nct) { const float* bq = biasT + (kr - g + 7) * 128 + 63 - qc + 4 * hi; const int tcs = 4 * hi - cs; na_adjust<0>(p0, bq, tcs, inv_scale); na_adjust<1>(p1, bq, tcs, inv_scale); }
      partialSM(p0, p1, m_reg, mn, al, C, thr_raw);
      ATT_RESC(al);
      finishSM(p0, p1, al, l_reg, pa0, pa1, pa2, pa3); ATT_SBAR();
      pv_d0(o, vb0 + buf * SHM_V, pa0, pa1, pa2, pa3);
    }
    if (t + 1 < NT) { asm volatile("s_waitcnt vmcnt(0)" ::: "memory"); ATT_SWRITE(buf ^ 1); }
    __syncthreads();
  }
  if (hi == 0) li_l[r32] = l_reg; asm volatile("s_waitcnt lgkmcnt(0)" ::: "memory");
  float rli[16];
#pragma unroll
  for (int r = 0; r < 16; ++r) rli[r] = __builtin_amdgcn_rcpf(li_l[crow(r, hi)]);
  bf16_t* Ow = Ob + (size_t)(wid * 32) * LDO;
#pragma unroll
  for (int r = 0; r < 16; ++r) { const int orow = crow(r, hi);
#pragma unroll
    for (int d0 = 0; d0 < 4; ++d0) Ow[(size_t)orow * LDO + d0 * 32 + r32] = f2bf(o[d0][r] * rli[r]); }
  __syncthreads();
#undef ATT_SLOAD
#undef ATT_SWRITE
#undef ATT_RESC
}
}

#ifndef ATT_ONLY
#define ATT_ONLY -1
#endif
__device__ __forceinline__ void phase_attn_mfma(KP P, int e, char* lds) {
    float* biasT = (float*)(lds + 2 * att::SHM_V + 2 * 64 * 512 + 8 * 64 * 4);
    constexpr float L2E = 1.4426950408889634f, SC_M = 0.07216878364870322f, SC_N = 0.08838834764831845f;
    const int G = (int)gridDim.x, xo = (G % 64 == 0) ? 1 : 0;
#define ATT_UNIT(u_) (xo ? (((u_) & 7) * 32 + ((u_) >> 3)) : (u_))
    if (ATT_ONLY < 0 || ATT_ONLY == 0)
    for (int u0 = blockIdx.x; u0 < 256; u0 += gridDim.x) {
        const int tid = tid_opaque(); const int u = ATT_UNIT(u0);
        const int b = u >> 6, hh = (u >> 3) & 7, qb = u & 7;
        const size_t qrow = (size_t)b * SEQ + qb * 256, crow0 = (size_t)MLAT + b * CTXL, lrow0 = (size_t)b * SEQ;
        att::attn_unit<192, false>(P->qm + qrow * 1536 + hh * 192, P->km + crow0 * 1536 + hh * 192, P->km + lrow0 * 1536 + hh * 192,
                                   P->vm + crow0 * 1024 + hh * 128, P->vm + lrow0 * 1024 + hh * 128, P->y + qrow * D + hh * 128,
                                   4, 36, 0, 0, biasT, SC_M * L2E, 8.0f / SC_M, 1.0f / SC_M, lds, tid);
    }
    if (ATT_ONLY < 0 || ATT_ONLY == 1)
    for (int u0 = blockIdx.x; u0 < 256; u0 += gridDim.x) {
        const int tid = tid_opaque(); const int u = ATT_UNIT(u0);
        const int b = u >> 6, hh = (u >> 3) & 7, qb = u & 7;
        const size_t qrow = (size_t)b * SEQ + qb * 256, crow0 = (size_t)MLAT + b * CTXL, lrow0 = (size_t)b * SEQ;
        const int g0 = qb * 4; int rs0 = g0 - 4; rs0 = rs0 < 0 ? 0 : (rs0 > 24 ? 24 : rs0); int rs3 = g0 + 3 - 4; rs3 = rs3 < 0 ? 0 : (rs3 > 24 ? 24 : rs3);
        const int nband = rs3 - rs0 + 8;
        for (int i = tid; i < 15 * 128; i += NTHR) { const int ro = i >> 7, dd = (i & 127) - 63; biasT[i] = (dd >= -15 && dd <= 15) ? P->rel_bias[(size_t)((e * 8 + hh) * 15 + ro) * 31 + dd + 15] : 0.f; }
        __syncthreads();
        att::attn_unit<128, true>(P->qn + qrow * 1024 + hh * 128, P->kn + crow0 * 1024 + hh * 128, P->kn + lrow0 * 1024 + hh * 128,
                                  P->vn + crow0 * 1024 + hh * 128, P->vn + lrow0 * 1024 + hh * 128, P->y + qrow * D + 1024 + hh * 128,
                                  4, 4 + nband, rs0, g0, biasT, SC_N * L2E, 8.0f / SC_N, 1.0f / SC_N, lds, tid);
    }
    if (ATT_ONLY < 0 || ATT_ONLY == 2)
    for (int u = blockIdx.x; u < 32; u += gridDim.x) {
        const int tid = tid_opaque();
        const int b = u >> 3, hh = u & 7; const size_t crow0 = (size_t)MLAT + b * CTXL;
        att::attn_unit<192, false>(P->qm + crow0 * 1536 + hh * 192, P->km + crow0 * 1536 + hh * 192, P->km + crow0 * 1536 + hh * 192,
                                   P->vm + crow0 * 1024 + hh * 128, P->vm + crow0 * 1024 + hh * 128, P->y + crow0 * D + hh * 128,
                                   4, 4, 0, 0, biasT, SC_M * L2E, 8.0f / SC_M, 1.0f / SC_M, lds, tid);
    }
    if (ATT_ONLY < 0 || ATT_ONLY == 3)
    for (int u = (G >= 64 ? (int)blockIdx.x - 32 : (int)blockIdx.x); u < 32; u += gridDim.x) { if (u < 0) continue;
        const int tid = tid_opaque();
        const int b = u >> 3, hh = u & 7; const size_t crow0 = (size_t)MLAT + b * CTXL;
        att::attn_unit<128, false>(P->qn + crow0 * 1024 + hh * 128, P->kn + crow0 * 1024 + hh * 128, P->kn + crow0 * 1024 + hh * 128,
                                   P->vn + crow0 * 1024 + hh * 128, P->vn + crow0 * 1024 + hh * 128, P->y + crow0 * D + 1024 + hh * 128,
                                   4, 4, 0, 0, biasT, SC_N * L2E, 8.0f / SC_N, 1.0f / SC_N, lds, tid);
    }
}

__device__ __forceinline__ int hg_seqrow(int b, int dir, int s) {
    if (dir == 0) return s < CTXL ? MLAT + b * CTXL + s : b * SEQ + (s - CTXL);
    return s < CTXL ? MLAT + b * CTXL + (CTXL - 1 - s) : b * SEQ + (SEQ - 1 - (s - CTXL));
}
namespace hg {
typedef short bf16x8 __attribute__((ext_vector_type(8)));
typedef float f32x4 __attribute__((ext_vector_type(4)));
constexpr int QS = 272, KTS = 144, VS = 144, PS = 144, SES = 272;
constexpr int OFF_Q = 0, OFF_K = OFF_Q + 64 * QS, OFF_KT = OFF_K + 64 * QS, OFF_V = OFF_KT + 128 * KTS, OFF_P = OFF_V + 32 * VS, OFF_SE = OFF_P + 64 * PS,
              OFF_SEG = OFF_SE + 32 * SES, OFF_E = OFF_SEG + 4 * 128 * 4, OFF_END = OFF_E + 3 * 128 * 4;
__device__ __forceinline__ bf16x8 frag(const char* base, int stride, int row, int kbyte) { return *reinterpret_cast<const bf16x8*>(base + row * stride + kbyte); }
}
__device__ __forceinline__ void phase_hgrn_pre(KP P, int o, char* lds) {
    using namespace hg;
    constexpr int VS2 = 144, OFF_V2 = OFF_KT + 128 * KTS, OFF_P2 = OFF_V2 + 128 * VS2, OFF_SEG2 = OFF_P2 + 64 * PS;
    const int tid = tid_opaque(), lane = tid & 63, w = tid >> 6, l15 = lane & 15, lq = lane >> 4;
    const int d2 = (tid & 63) * 2, tq = tid >> 6;
    char* Qt = lds + OFF_Q; char* Kt = lds + OFF_K; char* Ktt = lds + OFF_KT; char* Vt = lds + OFF_V2; char* Pm = lds + OFF_P2;
    float* seg = (float*)(lds + OFF_SEG2);
    const bf16_t* pb = P->p;
    for (int unit = blockIdx.x; unit < 64 * 36; unit += gridDim.x) {
        const int ud = unit / 36, c = unit % 36; const int dir = ud & 1, hd = (ud >> 1) & 7, b = ud >> 4;
        const float2 lbv = *(const float2*)(P->lb + (dir * 2 + o) * 1024 + hd * 128 + d2);
        const int zoff = dir ? 3072 : 2048;
        float qv[2][8], kk[2][8], cum[2][8];
        {
            unsigned qw[8], zw[8];
#pragma unroll
            for (int i = 0; i < 8; ++i) { const size_t row = hg_seqrow(b, dir, c * 64 + tq * 8 + i); qw[i] = *(const unsigned*)(pb + row * ODW + hd * 128 + d2); zw[i] = *(const unsigned*)(pb + row * ODW + zoff + hd * 128 + d2); }
            float run0 = 0.f, run1 = 0.f;
#pragma unroll
            for (int i = 0; i < 8; ++i) {
                float f0 = lbv.x + (1.0f - lbv.x) * sigmoid_f(bflo(zw[i])), f1 = lbv.y + (1.0f - lbv.y) * sigmoid_f(bfhi(zw[i]));
                f0 = fmaxf(f0, 1e-30f); f1 = fmaxf(f1, 1e-30f);
                run0 += __logf(f0); run1 += __logf(f1); cum[0][i] = run0; cum[1][i] = run1; kk[0][i] = 1.0f - f0; kk[1][i] = 1.0f - f1;
                qv[0][i] = silu_f(bflo(qw[i])); qv[1][i] = silu_f(bfhi(qw[i]));
            }
        }
        const int vs_ = tid >> 3, ve16 = (tid & 7) * 16;
        const uint4 vr0 = *(const uint4*)(pb + (size_t)hg_seqrow(b, dir, c * 64 + vs_) * ODW + 1024 + hd * 128 + ve16), vr1 = *(const uint4*)(pb + (size_t)hg_seqrow(b, dir, c * 64 + vs_) * ODW + 1024 + hd * 128 + ve16 + 8);
        __syncthreads();
        *(float2*)(seg + tq * 128 + d2) = make_float2(cum[0][7], cum[1][7]);
        __syncthreads();
        {
            float off0 = 0.f, off1 = 0.f, cr0 = 0.f, cr1 = 0.f, last0 = 0.f, last1 = 0.f;
#pragma unroll
            for (int g = 0; g < 8; ++g) { const float2 sg = *(const float2*)(seg + g * 128 + d2);
                if (g < tq) { off0 += sg.x; off1 += sg.y; } if (g < 4) { cr0 += sg.x; cr1 += sg.y; } last0 += sg.x; last1 += sg.y; }
            unsigned kt_pk[8];
#pragma unroll
            for (int i = 0; i < 8; ++i) {
                const float a0 = off0 + cum[0][i] - cr0, a1 = off1 + cum[1][i] - cr1; const int t = tq * 8 + i;
                const float q0 = qv[0][i] * __expf(fminf(a0, 80.f)), q1 = qv[1][i] * __expf(fminf(a1, 80.f));
                const float k0 = kk[0][i] * __expf(fminf(-a0, 80.f)), k1 = kk[1][i] * __expf(fminf(-a1, 80.f));
                const unsigned kp = cvt_pk_bf16(k0, k1); kt_pk[i] = kp;
                *(unsigned*)(Qt + t * QS + d2 * 2) = cvt_pk_bf16(q0, q1); *(unsigned*)(Kt + t * QS + d2 * 2) = kp;
            }
            uint4 r0, r1;
            r0.x = (kt_pk[0] & 0xffffu) | (kt_pk[1] << 16); r0.y = (kt_pk[2] & 0xffffu) | (kt_pk[3] << 16); r0.z = (kt_pk[4] & 0xffffu) | (kt_pk[5] << 16); r0.w = (kt_pk[6] & 0xffffu) | (kt_pk[7] << 16);
            r1.x = (kt_pk[0] >> 16) | (kt_pk[1] & 0xffff0000u); r1.y = (kt_pk[2] >> 16) | (kt_pk[3] & 0xffff0000u); r1.z = (kt_pk[4] >> 16) | (kt_pk[5] & 0xffff0000u); r1.w = (kt_pk[6] >> 16) | (kt_pk[7] & 0xffff0000u);
            *(uint4*)(Ktt + d2 * KTS + tq * 16) = r0; *(uint4*)(Ktt + (d2 + 1) * KTS + tq * 16) = r1;
            if (tq == 0) { float* g = P->he + (size_t)unit * 384;
                *(float2*)(g + d2) = make_float2(__expf(cr0), __expf(cr1)); *(float2*)(g + 128 + d2) = make_float2(__expf(last0), __expf(last1)); *(float2*)(g + 256 + d2) = make_float2(__expf(last0 - cr0), __expf(last1 - cr1)); }
            const unsigned vw[8] = {vr0.x, vr0.y, vr0.z, vr0.w, vr1.x, vr1.y, vr1.z, vr1.w};
#pragma unroll
            for (int j = 0; j < 8; ++j) { *(bf16_t*)(Vt + (ve16 + 2 * j) * VS2 + vs_ * 2) = (bf16_t)(vw[j] & 0xffffu); *(bf16_t*)(Vt + (ve16 + 2 * j + 1) * VS2 + vs_ * 2) = (bf16_t)(vw[j] >> 16); }
        }
        __syncthreads();
        {
            const int t = tid >> 3, c16 = (tid & 7) * 16;
            const uint4 x0 = *(const uint4*)(Qt + t * QS + c16 * 2), x1 = *(const uint4*)(Qt + t * QS + c16 * 2 + 16);
            bf16_t* g = P->hq + ((size_t)unit * 64 + t) * 128 + c16; *(uint4*)g = x0; *(uint4*)(g + 8) = x1;
        }
        {
            const int st = w & 3;
#pragma unroll
            for (int j = 0; j < 2; ++j) {
                const int tt = (w >> 2) * 2 + j;
                f32x4 acc = (f32x4){0.f, 0.f, 0.f, 0.f};
                if (st <= tt) {
#pragma unroll
                    for (int ks = 0; ks < 4; ++ks) { const int kb2 = (ks * 32 + 8 * lq) * 2;
                        acc = __builtin_amdgcn_mfma_f32_16x16x32_bf16(frag(Kt, QS, st * 16 + l15, kb2), frag(Qt, QS, tt * 16 + l15, kb2), acc, 0, 0, 0); }
                }
                const int s_i = st * 16 + 4 * lq, t_i = tt * 16 + l15;
                const float m0 = (st <= tt && s_i + 0 <= t_i) ? acc[0] : 0.f, m1 = (st <= tt && s_i + 1 <= t_i) ? acc[1] : 0.f;
                const float m2 = (st <= tt && s_i + 2 <= t_i) ? acc[2] : 0.f, m3 = (st <= tt && s_i + 3 <= t_i) ? acc[3] : 0.f;
                uint2 pk; pk.x = cvt_pk_bf16(m0, m1); pk.y = cvt_pk_bf16(m2, m3);
                *(uint2*)(Pm + t_i * PS + s_i * 2) = pk;
            }
        }
        {
            bf16_t* g = P->hu + (size_t)unit * 16384;
#pragma unroll
            for (int et = 0; et < 8; ++et) {
                f32x4 u = (f32x4){0.f, 0.f, 0.f, 0.f};
#pragma unroll
                for (int ks = 0; ks < 2; ++ks) { const int kb2 = (ks * 32 + 8 * lq) * 2;
                    u = __builtin_amdgcn_mfma_f32_16x16x32_bf16(frag(Ktt, KTS, w * 16 + l15, kb2), frag(Vt, VS2, et * 16 + l15, kb2), u, 0, 0, 0); }
                uint2 pk; pk.x = cvt_pk_bf16(u[0], u[1]); pk.y = cvt_pk_bf16(u[2], u[3]);
                *(uint2*)(g + ((size_t)(et * 8 + w) * 64 + lane) * 4) = pk;
            }
        }
        __syncthreads();
        {
            float* obuf = dir ? P->ob : P->of;
#pragma unroll
            for (int tt = 0; tt < 4; ++tt) {
                f32x4 acc = (f32x4){0.f, 0.f, 0.f, 0.f};
#pragma unroll
                for (int ks = 0; ks < 2; ++ks) { const int kb2 = (ks * 32 + 8 * lq) * 2;
                    acc = __builtin_amdgcn_mfma_f32_16x16x32_bf16(frag(Vt, VS2, w * 16 + l15, kb2), frag(Pm, PS, tt * 16 + l15, kb2), acc, 0, 0, 0); }
                const size_t row = hg_seqrow(b, dir, c * 64 + tt * 16 + l15);
                *(f32x4*)(obuf + row * 1024 + hd * 128 + w * 16 + 4 * lq) = acc;
            }
        }
    }
    __syncthreads();
}
__device__ __forceinline__ void phase_hgrn_seq(KP P, char* lds) {
    using namespace hg;
    const int tid = tid_opaque(), lane = tid & 63, w = tid >> 6, l15 = lane & 15, lq = lane >> 4;
    char* SEt0 = lds;
    for (int unit = blockIdx.x; unit < 256; unit += gridDim.x) {
        const int eb = unit & 3, ud = unit >> 2; const int dir = ud & 1, hd = (ud >> 1) & 7, b = ud >> 4;
        float* obuf = dir ? P->ob : P->of;
        const int et_o = w & 1, tt_o = w >> 1, dd = w * 16 + 4 * lq;
        f32x4 S[2]; S[0] = (f32x4){0.f, 0.f, 0.f, 0.f}; S[1] = S[0];
        bf16x8 qf[4]; uint2 uu[2]; f32x4 er4, el4, elr4, ov4;
#define HG_LOAD(c_) do { const size_t cu_ = (size_t)ud * 36 + (c_); const bf16_t* hq_ = P->hq + (cu_ * 64 + tt_o * 16 + l15) * 128 + 8 * lq; \
        _Pragma("unroll") for (int ks = 0; ks < 4; ++ks) qf[ks] = *reinterpret_cast<const bf16x8*>(hq_ + ks * 32); \
        const bf16_t* hu_ = P->hu + cu_ * 16384; \
        _Pragma("unroll") for (int et = 0; et < 2; ++et) uu[et] = *(const uint2*)(hu_ + ((size_t)((eb * 2 + et) * 8 + w) * 64 + lane) * 4); \
        const float* he_ = P->he + cu_ * 384 + dd; er4 = *(const f32x4*)he_; el4 = *(const f32x4*)(he_ + 128); elr4 = *(const f32x4*)(he_ + 256); \
        ov4 = *(const f32x4*)(obuf + (size_t)hg_seqrow(b, dir, (c_) * 64 + tt_o * 16 + l15) * 1024 + hd * 128 + eb * 32 + et_o * 16 + 4 * lq); } while (0)
        HG_LOAD(0);
        __syncthreads();
#pragma nounroll
        for (int c = 0; c < 36; ++c) {
            char* SEt = SEt0 + (c & 1) * (32 * SES);
#pragma unroll
            for (int et = 0; et < 2; ++et) { const f32x4 v4 = S[et] * er4; uint2 pk; pk.x = cvt_pk_bf16(v4[0], v4[1]); pk.y = cvt_pk_bf16(v4[2], v4[3]);
                *(uint2*)(SEt + (et * 16 + l15) * SES + dd * 2) = pk; }
            const bf16x8 q0 = qf[0], q1 = qf[1], q2 = qf[2], q3 = qf[3]; const uint2 u0 = uu[0], u1 = uu[1]; const f32x4 el = el4, elr = elr4, ov = ov4;
            __syncthreads();
            if (c + 1 < 36) HG_LOAD(c + 1);
            f32x4 acc = (f32x4){0.f, 0.f, 0.f, 0.f};
            acc = __builtin_amdgcn_mfma_f32_16x16x32_bf16(frag(SEt, SES, et_o * 16 + l15, (0 * 32 + 8 * lq) * 2), q0, acc, 0, 0, 0);
            acc = __builtin_amdgcn_mfma_f32_16x16x32_bf16(frag(SEt, SES, et_o * 16 + l15, (1 * 32 + 8 * lq) * 2), q1, acc, 0, 0, 0);
            acc = __builtin_amdgcn_mfma_f32_16x16x32_bf16(frag(SEt, SES, et_o * 16 + l15, (2 * 32 + 8 * lq) * 2), q2, acc, 0, 0, 0);
            acc = __builtin_amdgcn_mfma_f32_16x16x32_bf16(frag(SEt, SES, et_o * 16 + l15, (3 * 32 + 8 * lq) * 2), q3, acc, 0, 0, 0);
            float* op = obuf + (size_t)hg_seqrow(b, dir, c * 64 + tt_o * 16 + l15) * 1024 + hd * 128 + eb * 32 + et_o * 16 + 4 * lq;
            *(f32x4*)op = ov + acc;
            const f32x4 U0 = (f32x4){bflo(u0.x), bfhi(u0.x), bflo(u0.y), bfhi(u0.y)}, U1 = (f32x4){bflo(u1.x), bfhi(u1.x), bflo(u1.y), bfhi(u1.y)};
            S[0] = el * S[0] + elr * U0; S[1] = el * S[1] + elr * U1;
        }
        __syncthreads();
#undef HG_LOAD
    }
}

__device__ __forceinline__ void phase_hgrn_readout(KP P, int o, int M) {
    const int tid = tid_opaque(), lane = tid & 63, w = tid >> 6;
    for (int u = blockIdx.x * 8 + w; u < M * 8; u += gridDim.x * 8) {
        const int row = u >> 3, hd = u & 7;
        const size_t off = (size_t)row * 1024 + hd * 128 + lane * 2;
        const float2 a = *(const float2*)(P->of + off), bq = *(const float2*)(P->ob + off);
        const float v0 = a.x + bq.x, v1 = a.y + bq.y;
        float ss = wave_sum(v0 * v0 + v1 * v1);
        const float rstd = rsqrtf(ss * (1.0f / 128.0f) + NORM_EPS);
        const float2 g = *(const float2*)(P->hgrn_norm_g + o * 1024 + hd * 128 + lane * 2);
        const unsigned gtw = *(const unsigned*)(P->p + (size_t)row * ODW + 4096 + hd * 128 + lane * 2); const float2 gt = make_float2(bflo(gtw), bfhi(gtw));
        *(unsigned*)(P->y + (size_t)row * D + hd * 128 + lane * 2) = cvt_pk_bf16(v0 * rstd * g.x * silu_f(gt.x), v1 * rstd * g.y * silu_f(gt.y));
    }
}

__device__ __forceinline__ void phase_hyena_prep(KP P, int o, int M) {
    const float* cw = P->conv_w + (size_t)o * 3 * 3072; const float* cb = P->conv_b + o * 3072;
    const size_t total = (size_t)M * 128;
    for (size_t i = (size_t)blockIdx.x * NTHR + tid_opaque(); i < total; i += (size_t)gridDim.x * NTHR) {
        const int row = (int)(i >> 7), c8 = (int)(i & 127) * 8;
        int t, n;
        if (row < MLAT) { t = row & (SEQ - 1); n = SEQ; } else { t = (row - MLAT) & (CTXL - 1); n = CTXL; }
        const bf16_t* u = P->p + (size_t)row * ODW + 5120;
        float r3[3][8];
#pragma unroll
        for (int part = 0; part < 3; ++part) {
            const int j = part * 1024 + c8;
            const uint4 x1 = *(const uint4*)(u + j);
            uint4 x0 = make_uint4(0u, 0u, 0u, 0u), x2 = x0;
            if (t > 0) x0 = *(const uint4*)(u + j - ODW);
            if (t < n - 1) x2 = *(const uint4*)(u + j + ODW);
            const float4 b0 = *(const float4*)(cb + j), b1 = *(const float4*)(cb + j + 4);
            const float4 w00 = *(const float4*)(cw + j), w01 = *(const float4*)(cw + j + 4), w10 = *(const float4*)(cw + 3072 + j), w11 = *(const float4*)(cw + 3072 + j + 4),
                         w20 = *(const float4*)(cw + 6144 + j), w21 = *(const float4*)(cw + 6144 + j + 4);
            const float bb[8] = {b0.x, b0.y, b0.z, b0.w, b1.x, b1.y, b1.z, b1.w};
            const float wa[8] = {w00.x, w00.y, w00.z, w00.w, w01.x, w01.y, w01.z, w01.w}, wb[8] = {w10.x, w10.y, w10.z, w10.w, w11.x, w11.y, w11.z, w11.w},
                        wc[8] = {w20.x, w20.y, w20.z, w20.w, w21.x, w21.y, w21.z, w21.w};
            const unsigned xa[4] = {x0.x, x0.y, x0.z, x0.w}, xb[4] = {x1.x, x1.y, x1.z, x1.w}, xc[4] = {x2.x, x2.y, x2.z, x2.w};
#pragma unroll
            for (int q = 0; q < 4; ++q) {
                r3[part][2 * q]     = bb[2 * q]     + wa[2 * q]     * bflo(xa[q]) + wb[2 * q]     * bflo(xb[q]) + wc[2 * q]     * bflo(xc[q]);
                r3[part][2 * q + 1] = bb[2 * q + 1] + wa[2 * q + 1] * bfhi(xa[q]) + wb[2 * q + 1] * bfhi(xb[q]) + wc[2 * q + 1] * bfhi(xc[q]);
            }
        }
        float* zx = P->x0b + (size_t)row * 1024 + c8; float* zz = P->zb + (size_t)row * 1024 + c8;
        *(float4*)zx = make_float4(r3[0][0], r3[0][1], r3[0][2], r3[0][3]); *(float4*)(zx + 4) = make_float4(r3[0][4], r3[0][5], r3[0][6], r3[0][7]);
        *(float4*)zz = make_float4(r3[2][0] * r3[1][0], r3[2][1] * r3[1][1], r3[2][2] * r3[1][2], r3[2][3] * r3[1][3]);
        *(float4*)(zz + 4) = make_float4(r3[2][4] * r3[1][4], r3[2][5] * r3[1][5], r3[2][6] * r3[1][6], r3[2][7] * r3[1][7]);
    }
}
__device__ __forceinline__ void phase_hyena_conv(KP P, int o, bool do_lat, bool do_ctx, float* lds) {
    (void)do_lat;
    if (!do_ctx) return;
    float* hb = lds;
    float* zs = lds + 511 * 32;
    const int tid = tid_opaque(), c = tid & 31, tg = tid >> 5;
    const float* hf = P->filt_ctx + ((size_t)o * 2 + 0) * CTXL * 1024; const float* hbw = P->filt_ctx + ((size_t)o * 2 + 1) * CTXL * 1024;
    for (int unit = blockIdx.x; unit < 4 * 32; unit += gridDim.x) {
        const int b = unit >> 5, c0 = (unit & 31) * 32; const size_t seqbase = (size_t)MLAT + b * CTXL;
        __syncthreads();
        for (int idx = tid; idx < 511 * 32; idx += NTHR) { const int jj = idx >> 5, cc = idx & 31; const int j = jj - 255;
            hb[idx] = j >= 0 ? hf[(size_t)j * 1024 + c0 + cc] : hbw[(size_t)(-j) * 1024 + c0 + cc]; }
        for (int idx = tid; idx < 256 * 32; idx += NTHR) { const int s2 = idx >> 5, cc = idx & 31; zs[idx] = P->zb[(seqbase + s2) * 1024 + c0 + cc]; }
        __syncthreads();
        float acc[16];
#pragma unroll
        for (int i = 0; i < 16; ++i) acc[i] = 0.f;
#pragma unroll 4
        for (int s2 = 0; s2 < 256; ++s2) {
            const float zv = zs[s2 * 32 + c];
            const float* hp = hb + (tg * 16 - s2 + 255) * 32 + c;
#pragma unroll
            for (int i = 0; i < 16; ++i) acc[i] += hp[i * 32] * zv;
        }
        const float sk = P->skip[o * 1024 + c0 + c];
#pragma unroll
        for (int i = 0; i < 16; ++i) {
            const size_t row = seqbase + tg * 16 + i;
            const float zt = zs[(tg * 16 + i) * 32 + c], x0 = P->x0b[row * 1024 + c0 + c];
            P->y[row * D + 1024 + c0 + c] = f2bf(x0 * (acc[i] + zt * sk));
        }
    }
}

namespace fftc {
constexpr int SEQP = 4096 + 512;
__device__ __forceinline__ int fphys(int i) { return i + (i >> 3); }
__device__ __forceinline__ float2 cmul(float2 a, float2 b) { return make_float2(a.x * b.x - a.y * b.y, a.x * b.y + a.y * b.x); }
__device__ __forceinline__ float2 cmulc(float2 a, float2 b) { return make_float2(a.x * b.x + a.y * b.y, a.y * b.x - a.x * b.y); }
__device__ __forceinline__ float2 cadd(float2 a, float2 b) { return make_float2(a.x + b.x, a.y + b.y); }
__device__ __forceinline__ float2 csub(float2 a, float2 b) { return make_float2(a.x - b.x, a.y - b.y); }
template <int S, bool INV> __device__ __forceinline__ void pass(float2* X, const float2* tw, int tid) {
    const int blk = tid / S, j0 = tid % S, e0 = blk * 8 * S + j0;
    float2 v[8];
#pragma unroll
    for (int k = 0; k < 8; ++k) v[k] = X[fphys(e0 + k * S)];
    const float2 wA0 = tw[j0 * (512 / S)], wB0 = cmul(wA0, wA0), wC = cmul(wB0, wB0);
    constexpr float R = 0.70710678118654752f;
    const float2 w8[4] = {make_float2(1.f, 0.f), make_float2(R, -R), make_float2(0.f, -1.f), make_float2(-R, -R)};
    const float2 wBk[2] = {wB0, make_float2(wB0.y, -wB0.x)};
    if (!INV) {
#pragma unroll
        for (int k = 0; k < 4; ++k) { const float2 a = v[k], b = v[k + 4]; v[k] = cadd(a, b); v[k + 4] = cmul(csub(a, b), cmul(wA0, w8[k])); }
#pragma unroll
        for (int base = 0; base < 8; base += 4)
#pragma unroll
            for (int k = 0; k < 2; ++k) { const float2 a = v[base + k], b = v[base + k + 2]; v[base + k] = cadd(a, b); v[base + k + 2] = cmul(csub(a, b), wBk[k]); }
#pragma unroll
        for (int k = 0; k < 8; k += 2) { const float2 a = v[k], b = v[k + 1]; v[k] = cadd(a, b); v[k + 1] = cmul(csub(a, b), wC); }
    } else {
#pragma unroll
        for (int k = 0; k < 8; k += 2) { const float2 a = v[k], b = cmulc(v[k + 1], wC); v[k] = cadd(a, b); v[k + 1] = csub(a, b); }
#pragma unroll
        for (int base = 0; base < 8; base += 4)
#pragma unroll
            for (int k = 0; k < 2; ++k) { const float2 a = v[base + k], b = cmulc(v[base + k + 2], wBk[k]); v[base + k] = cadd(a, b); v[base + k + 2] = csub(a, b); }
#pragma unroll
        for (int k = 0; k < 4; ++k) { const float2 a = v[k], b = cmulc(v[k + 4], cmul(wA0, w8[k])); v[k] = cadd(a, b); v[k + 4] = csub(a, b); }
    }
#pragma unroll
    for (int k = 0; k < 8; ++k) X[fphys(e0 + k * S)] = v[k];
}
template <int S, bool INV> __device__ __forceinline__ void pass4(float2* X, const float2* tw, int tid) {
#pragma nounroll
    for (int q = 0; q < 4; ++q) pass<S, INV>(X + q * SEQP, tw, tid);
    __syncthreads();
}
__device__ __forceinline__ void fwd4(float2* X, const float2* tw, int tid) { pass4<512, false>(X, tw, tid); pass4<64, false>(X, tw, tid); pass4<8, false>(X, tw, tid); pass4<1, false>(X, tw, tid); }
__device__ __forceinline__ void inv4(float2* X, const float2* tw, int tid) { pass4<1, true>(X, tw, tid); pass4<8, true>(X, tw, tid); pass4<64, true>(X, tw, tid); pass4<512, true>(X, tw, tid); }
__device__ __forceinline__ void init_tw(float2* tw, int tid) { if (tid < 512) { float sn, cs; sincospif((float)tid * (1.0f / 2048.0f), &sn, &cs); tw[tid] = make_float2(cs, -sn); } }
}

__device__ __forceinline__ void phase_filter_fft(KP P, char* lds) {
    const int tid = tid_opaque();
    float2* X = (float2*)lds; float2* tw = X + 4 * fftc::SEQP;
    fftc::init_tw(tw, tid);
    for (int unit = blockIdx.x; unit < 512; unit += gridDim.x) {
        const int o = unit >> 8, c0 = (unit & 255) * 4;
        const float* hf = P->filt_lat + ((size_t)o * 2 + 0) * SEQ * 1024 + c0; const float* hb = P->filt_lat + ((size_t)o * 2 + 1) * SEQ * 1024 + c0;
        __syncthreads();
        for (int i = tid; i < 4096; i += NTHR) {
            float4 val = make_float4(0.f, 0.f, 0.f, 0.f);
            if (i < 2048) val = *(const float4*)(hf + (size_t)i * 1024); else if (i > 2048) val = *(const float4*)(hb + (size_t)(4096 - i) * 1024);
            if (i == 0) { const float4 sk = *(const float4*)(P->skip + o * 1024 + c0); val.x += sk.x; val.y += sk.y; val.z += sk.z; val.w += sk.w; }
            const int p = fftc::fphys(i);
            X[p] = make_float2(val.x, 0.f); X[fftc::SEQP + p] = make_float2(val.y, 0.f); X[2 * fftc::SEQP + p] = make_float2(val.z, 0.f); X[3 * fftc::SEQP + p] = make_float2(val.w, 0.f);
        }
        __syncthreads();
        fftc::fwd4(X, tw, tid);
        for (int q = 0; q < 4; ++q) { float2* dst = P->kf + ((size_t)o * 1024 + c0 + q) * 4096;
            for (int i = tid; i < 4096; i += NTHR) { const float2 v = X[q * fftc::SEQP + fftc::fphys(i)]; dst[i] = make_float2(v.x * (1.0f / 4096.0f), v.y * (1.0f / 4096.0f)); } }
    }
}
__device__ __forceinline__ void phase_hyena_fft(KP P, int o, char* lds) {
    const int tid = tid_opaque();
    float2* X = (float2*)lds; float2* tw = X + 4 * fftc::SEQP; float* Xf = (float*)lds;
    fftc::init_tw(tw, tid);
    for (int unit = blockIdx.x; unit < 512; unit += gridDim.x) {
        const int c0 = (unit >> 1) * 4, b0 = (unit & 1) * 2;
        __syncthreads();
        for (int i = tid; i < 4096; i += NTHR) {
            const int t = i & 2047, bb = i >> 11; const size_t row = (size_t)(b0 + bb) * SEQ + t;
            const float4 val = *(const float4*)(P->zb + row * 1024 + c0);
            const int p = fftc::fphys(t);
            Xf[2 * p + bb] = val.x; Xf[2 * (fftc::SEQP + p) + bb] = val.y; Xf[2 * (2 * fftc::SEQP + p) + bb] = val.z; Xf[2 * (3 * fftc::SEQP + p) + bb] = val.w;
        }
        for (int i = tid; i < 2048; i += NTHR) { const int p = fftc::fphys(2048 + i); const float2 z2 = make_float2(0.f, 0.f);
            X[p] = z2; X[fftc::SEQP + p] = z2; X[2 * fftc::SEQP + p] = z2; X[3 * fftc::SEQP + p] = z2; }
        __syncthreads();
        fftc::fwd4(X, tw, tid);
        for (int q = 0; q < 4; ++q) { const float2* kfp = P->kf + ((size_t)o * 1024 + c0 + q) * 4096;
            for (int i = tid; i < 4096; i += NTHR) { const int p = q * fftc::SEQP + fftc::fphys(i); X[p] = fftc::cmul(X[p], kfp[i]); } }
        __syncthreads();
        fftc::inv4(X, tw, tid);
        for (int i = tid; i < 4096; i += NTHR) {
            const int t = i & 2047, bb = i >> 11; const size_t row = (size_t)(b0 + bb) * SEQ + t;
            const int p = fftc::fphys(t);
            const float4 x0 = *(const float4*)(P->x0b + row * 1024 + c0);
            const float y0 = x0.x * Xf[2 * p + bb], y1 = x0.y * Xf[2 * (fftc::SEQP + p) + bb];
            const float y2 = x0.z * Xf[2 * (2 * fftc::SEQP + p) + bb], y3 = x0.w * Xf[2 * (3 * fftc::SEQP + p) + bb];
            uint2 w; w.x = cvt_pk_bf16(y0, y1); w.y = cvt_pk_bf16(y2, y3);
            *(uint2*)(P->y + row * D + 1024 + c0) = w;
        }
    }
}

__device__ __forceinline__ void phase_final(KP P) {
    const int tid = tid_opaque(), lane = tid & 63, w = tid >> 6;
    for (int row = blockIdx.x * 8 + w; row < MLAT; row += gridDim.x * 8) {
        const float* hr = P->h + (size_t)row * D;
        float4 v[8]; float ss = 0.f;
#pragma unroll
        for (int i = 0; i < 8; ++i) { v[i] = *(const float4*)(hr + i * 256 + lane * 4); ss += v[i].x * v[i].x + v[i].y * v[i].y + v[i].z * v[i].z + v[i].w * v[i].w; }
        ss = wave_sum(ss);
        const float rstd = rsqrtf(ss * (1.0f / D) + NORM_EPS);
        float* orow = P->out + (size_t)row * D;
#pragma unroll
        for (int i = 0; i < 8; ++i) {
            const int col = i * 256 + lane * 4;
            const float4 gg = *(const float4*)(P->final_norm_g + col);
            *(float4*)(orow + col) = make_float4(v[i].x * rstd * gg.x, v[i].y * rstd * gg.y, v[i].z * rstd * gg.z, v[i].w * rstd * gg.w);
        }
    }
}

__global__ void __launch_bounds__(NTHR, 2) mega(Params Pk) {
    extern __shared__ __attribute__((aligned(16))) unsigned char lds_raw[];
    float* lds = (float*)lds_raw;
    volatile LAS unsigned* barw = (volatile LAS unsigned*)((LAS unsigned char*)lds_raw + LDS_BARW_OFF);
    if (threadIdx.x < 4) barw[threadIdx.x] = 0u;
    __syncthreads();
    XcdBarrier bar; bar.bar = Pk.bar; bar.x = 0; bar.st = barw;
    const int lo = Pk.ph_lo, hi = Pk.ph_hi;
    if (hi - lo > 1) bar = xcd_barrier_post(Pk.bar, barw);
    int ph = 0;
#ifndef ONLY_SITE
#define ONLY_SITE -1
#endif
#ifndef DUP_SITE
#define DUP_SITE -1
#endif
#define PHASE(id, body) do { if (ONLY_SITE < 0 || ONLY_SITE == (id)) { if (ph >= lo && ph < hi) { KP P = kargs(); int reps_ = 1; if (DUP_SITE == (id)) { reps_ = 2; asm volatile("" : "+s"(reps_)); } for (int rep_ = 0; rep_ < reps_; ++rep_) { body; if (rep_ + 1 < reps_) __syncthreads(); } if (ph + 1 < hi) xcd_barrier(bar); } } ++ph; } while (0)

    LAS unsigned char* ldsl = (LAS unsigned char*)lds_raw;
    PHASE(0, (phase_prologue(P, lds), phase_convert_weights<0>(P, lds, (int)blockIdx.x, (int)gridDim.x)));
    for (int l = 0; l < DEPTH; ++l) {
        const bool ctx_out = l < DEPTH - 1;
        const int Mo = ctx_out ? MTOT : MLAT;
        PHASE(1, (phase_norm(P, l, 0, MTOT, l > 0, (l & 1) == 0), (l == 0 ? phase_filter_fft(P, (char*)lds_raw) : (void)0)));
        if ((l & 1) == 0) {
            const int e = l >> 1;
            PHASE(2, (run_gemm(ldsl, P->a, P->wt_ev + (size_t)e * EVP * D, MTOT, EVP, D, EpiEvenRoute{P->qm, P->ckv, P->qn, P->kn, P->vn, P->kpe, P->ssq})));
            PHASE(4, (phase_rope_fix(P), run_gemm(ldsl, P->ckv, P->wt_ukv + (size_t)e * D * 512, MTOT, D, 512, EpiKV{P->km, P->vm, P->ssq})));
            PHASE(5, phase_attn_mfma(P, e, (char*)lds_raw));
        } else {
            const int o = l >> 1;
            PHASE(6, (run_gemm(ldsl, P->a, P->wt_od + (size_t)o * ODW * D, MTOT, ODW, D, EpiStoreBf16{P->p, ODW}),
                      ((l == 1 && gridDim.x == 256 && blockIdx.x >= 128) ? phase_convert_weights<2>(P, lds, (int)blockIdx.x - 128, 128) : (void)0),
                      ((l == 1 && gridDim.x != 256) ? phase_convert_weights<2>(P, lds, (int)blockIdx.x, (int)gridDim.x) : (void)0)));
            PHASE(7, (phase_hgrn_pre(P, o, (char*)lds_raw), phase_hyena_prep(P, o, MTOT)));
            PHASE(16, (phase_hgrn_seq(P, (char*)lds_raw), phase_hyena_fft(P, o, (char*)lds_raw), phase_hyena_conv(P, o, false, ctx_out, lds)));
            PHASE(8, phase_hgrn_readout(P, o, Mo));
        }
        PHASE(9, (run_gemm_split(ldsl, P->y, P->wt_out + (size_t)l * D * D, Mo, D, D, EpiResid{P->h, P->mod + (size_t)l * 5 * 6 * D + 2 * D, P->kv})));
        PHASE(10, phase_norm(P, l, 1, Mo, ctx_out, false));
        PHASE(11, (run_gemm(ldsl, P->a, P->wt_w1 + (size_t)l * HID * D, Mo, HID, D, EpiRelu2Bf16{P->u, HID}),
                   ((l < DEPTH - 1 && gridDim.x == 256 && blockIdx.x >= 128) ? phase_adaln(P, lds, l + 1, (int)blockIdx.x - 128, 128) : (void)0),
                   ((l < DEPTH - 1 && gridDim.x != 256) ? phase_adaln(P, lds, l + 1, (int)blockIdx.x, (int)gridDim.x) : (void)0),
                   ((l == 1 && gridDim.x == 256 && blockIdx.x >= 128) ? phase_convert_weights<1>(P, lds, (int)blockIdx.x - 128, 128) : (void)0),
                   ((l == 1 && gridDim.x != 256) ? phase_convert_weights<1>(P, lds, (int)blockIdx.x, (int)gridDim.x) : (void)0)));
        PHASE(12, (run_gemm_split(ldsl, P->u, P->wt_w2 + (size_t)l * D * HID, Mo, D, HID, EpiResid{P->h, P->mod + (size_t)l * 5 * 6 * D + 5 * D, P->kv})));
    }
    PHASE(13, phase_final(P));
#undef PHASE
}

constexpr int N_PHASES = 1 + 2 * (1 + 3 + 4) + 2 * (1 + 4 + 4) + 1;

extern "C" void kernel_launch(void* const* d_in, const int* in_sizes, int n_in, void* d_out, int out_size, void* d_ws, size_t ws_size, hipStream_t stream) {
    static int grid = 0;
    if (grid == 0) {
        if (n_in != 30 || out_size != MLAT * D || ws_size < WS_END) {
            fprintf(stderr, "kernel_launch: unexpected sizes n_in %d out %d ws %zu (need %zu)\n", n_in, out_size, ws_size, (size_t)WS_END); grid = -1; return;
        }
        int dev = 0, cus = 0, per_cu = 0;
        if (hipGetDevice(&dev) != hipSuccess || hipDeviceGetAttribute(&cus, hipDeviceAttributeMultiprocessorCount, dev) != hipSuccess) { grid = -1; return; }
        if (hipFuncSetAttribute((const void*)mega, hipFuncAttributeMaxDynamicSharedMemorySize, LDS_BYTES) != hipSuccess) { fprintf(stderr, "kernel_launch: hipFuncSetAttribute failed\n"); grid = -1; return; }
        if (hipOccupancyMaxActiveBlocksPerMultiprocessor(&per_cu, (const void*)mega, NTHR, LDS_BYTES) != hipSuccess || per_cu < 1)
            fprintf(stderr, "kernel_launch: occupancy query reports %d blocks per CU\n", per_cu);
        (void)hipGetLastError();
        grid = cus;
    }
    if (grid < 0) return;
    (void)hipMemsetAsync((char*)d_ws + WS_BAR, 0, XCD_BAR_WORDS * 4, stream);
    Params P; memset(&P, 0, sizeof(P));
    const float** ip = (const float**)&P;
    for (int i = 0; i < 30; ++i) ip[i] = (const float*)d_in[i];
    P.out = (float*)d_out;
    char* ws = (char*)d_ws;
    P.bar = (unsigned*)(ws + WS_BAR);
    P.mod = (float*)(ws + WS_MOD); P.lb = (float*)(ws + WS_LB); P.rope = (float*)(ws + WS_ROPE);
    P.h = (float*)(ws + WS_H); P.a = (bf16_t*)(ws + WS_A); P.p = (bf16_t*)(ws + WS_P); P.kv = (float*)(ws + WS_KV);
    P.ckvn = (bf16_t*)(ws + WS_CKVN); P.y = (bf16_t*)(ws + WS_Y); P.u = (bf16_t*)(ws + WS_U); P.filt_lat = (float*)(ws + WS_FLAT); P.filt_ctx = (float*)(ws + WS_FCTX);
    P.zb = (float*)(ws + WS_ZB); P.x0b = (float*)(ws + WS_X0B); P.of = (float*)(ws + WS_OF); P.ob = (float*)(ws + WS_OB);
    P.wt_ev = (bf16_t*)(ws + WS_WEV); P.wt_od = (bf16_t*)(ws + WS_WOD); P.wt_ukv = (bf16_t*)(ws + WS_WUKV); P.wt_out = (bf16_t*)(ws + WS_WOUT);
    P.wt_w1 = (bf16_t*)(ws + WS_WW1); P.wt_w2 = (bf16_t*)(ws + WS_WW2);
    P.qm = (bf16_t*)(ws + WS_QM); P.km = (bf16_t*)(ws + WS_KM); P.vm = (bf16_t*)(ws + WS_VM);
    P.qn = (bf16_t*)(ws + WS_QN); P.kn = (bf16_t*)(ws + WS_KN); P.vn = (bf16_t*)(ws + WS_VN);
    P.kf = (float2*)(ws + WS_KF); P.ckv = (bf16_t*)(ws + WS_CKV); P.kpe = (bf16_t*)(ws + WS_KPE); P.hq = (bf16_t*)(ws + WS_HQ); P.hu = (bf16_t*)(ws + WS_HU); P.he = (float*)(ws + WS_HE); P.ssq = (float*)(ws + WS_SSQ);
#if MK_MULTI
    for (int i = 0; i < N_PHASES; ++i) {
        P.ph_lo = i; P.ph_hi = i + 1;
        hipLaunchKernelGGL(mega, dim3(grid), dim3(NTHR), LDS_BYTES, stream, P);
    }
#else
    P.ph_lo = 0; P.ph_hi = N_PHASES;
    hipLaunchKernelGGL(mega, dim3(grid), dim3(NTHR), LDS_BYTES, stream, P);
#endif
    const hipError_t le = hipPeekAtLastError();
    if (le != hipSuccess) fprintf(stderr, "kernel_launch: launch failed: %s\n", hipGetErrorName(le));
}
```

```cpp
#include <hip/hip_runtime.h>
#include <stdint.h>
#include <stdio.h>
#include <string.h>

#ifndef MK_MULTI
#define MK_MULTI 0
#endif

constexpr int D = 2048, NB = 4, SEQ = 2048, CTXL = 256, DEPTH = 4;
constexpr int MLAT = NB * SEQ, MCTX = NB * CTXL, MTOT = MLAT + MCTX;
constexpr int EVW = 5184, EVP = 5376, ODW = 8192, HID = 8192;
constexpr int NTHR = 512;
constexpr float NORM_EPS = 1e-6f;

#define XB_TMO      128
#define XB_XCNT(j)  (256  + 64 * (j))
#define XB_XSUB(j)  (1280 + 64 * (j))
#define XB_XGEN(j)  (2304 + 64 * (j))
#define XB_TOP      3328
#define XB_TOPGEN   3392
#define XCD_BAR_WORDS 3456
#define XB_SPIN_CAP (1u << 23)
#define LAS __attribute__((address_space(3)))

__device__ __forceinline__ unsigned xb_ld(unsigned* p)              { return __hip_atomic_load(p, __ATOMIC_RELAXED, __HIP_MEMORY_SCOPE_AGENT); }
__device__ __forceinline__ unsigned xb_add(unsigned* p, unsigned v) { return __hip_atomic_fetch_add(p, v, __ATOMIC_RELAXED, __HIP_MEMORY_SCOPE_AGENT); }
__device__ __forceinline__ unsigned xb_xcc_id() { return (unsigned)__builtin_amdgcn_s_getreg((3 << 11) | 20) & 0xFu; }
#define XB_SPIN(cond, bar) do { unsigned _sp = 0; while (cond) { __builtin_amdgcn_s_sleep(1); \
    if ((++_sp & 255u) == 0u) { if (xb_ld(&(bar)[XB_TMO])) break; if (_sp > XB_SPIN_CAP) { atomicAdd(&(bar)[XB_TMO], 1u); break; } } } } while (0)

struct XcdBarrier { unsigned* bar; unsigned x; volatile LAS unsigned* st; };

__device__ __forceinline__ XcdBarrier xcd_barrier_post(unsigned* bar, volatile LAS unsigned* st) {
    XcdBarrier b; b.bar = bar; b.x = xb_xcc_id(); b.st = st;
    if (threadIdx.x == 0) (void)xb_add(&bar[XB_XCNT(b.x)], 1u);
    return b;
}
__device__ __forceinline__ void xcd_barrier_complete(unsigned* bar, unsigned x, unsigned& nloc, unsigned& nx) {
    const unsigned G = gridDim.x * gridDim.y * gridDim.z;
    unsigned sum, cnt, mine, sp = 0u;
    for (;;) {
        sum = 0u; cnt = 0u; mine = 0u;
#pragma unroll
        for (unsigned j = 0; j < 16; ++j) { const unsigned c = xb_ld(&bar[XB_XCNT(j)]); sum += c; cnt += (c > 0u) ? 1u : 0u; mine = (j == x) ? c : mine; }
        if (sum == G) break;
        __builtin_amdgcn_s_sleep(1);
        if ((++sp & 255u) == 0u) { if (xb_ld(&bar[XB_TMO])) break; if (sp > XB_SPIN_CAP) { atomicAdd(&bar[XB_TMO], 1u); break; } }
    }
    nloc = mine > 0u ? mine : 1u; nx = cnt > 0u ? cnt : 1u;
}
__device__ __forceinline__ void xcd_barrier(const XcdBarrier& b) {
    asm volatile("s_waitcnt vmcnt(0)" ::: "memory");
    __syncthreads();
    if (threadIdx.x == 0) {
        unsigned* bar = b.bar;
        __builtin_amdgcn_s_waitcnt(0);
        unsigned nloc = b.st[0], nx = b.st[1];
        if (nloc == 0u) { xcd_barrier_complete(bar, b.x, nloc, nx); b.st[0] = nloc; b.st[1] = nx; }
        const unsigned old = xb_add(&bar[XB_XSUB(b.x)], 1u);
        const unsigned gen = old / nloc;
        if (old + 1u == (gen + 1u) * nloc) {
            __builtin_amdgcn_fence(__ATOMIC_RELEASE, "agent");
            asm volatile("s_waitcnt vmcnt(0)" ::: "memory");
            const unsigned og = xb_add(&bar[XB_TOP], 1u);
            const unsigned tg = og / nx;
            if (og + 1u == (tg + 1u) * nx) xb_add(&bar[XB_TOPGEN], 1u);
            else XB_SPIN(xb_ld(&bar[XB_TOPGEN]) == tg, bar);
            __builtin_amdgcn_fence(__ATOMIC_ACQUIRE, "agent");
            xb_add(&bar[XB_XGEN(b.x)], 1u);
            asm volatile("s_waitcnt vmcnt(0)" ::: "memory");
        } else {
            XB_SPIN(xb_ld(&bar[XB_XGEN(b.x)]) == gen, bar);
            __builtin_amdgcn_fence(__ATOMIC_ACQUIRE, "agent");
            asm volatile("s_waitcnt vmcnt(0)" ::: "memory");
        }
    }
    __syncthreads();
}

typedef unsigned short bf16_t;
struct Params {
    const float *x, *c, *ctx, *c_ctx, *ada_w, *ada_b, *norm_mix_g, *norm_mlp_g, *w_out, *mlp_w1, *mlp_w2, *final_norm_g,
        *ev_w_in, *kv_norm_g, *w_ukv, *rel_bias, *od_w_in, *lb_logits, *hgrn_norm_g, *conv_w, *conv_b,
        *fw1, *fb1, *fw2, *fb2, *fw3, *fb3, *ffreq, *fwout, *skip;
    float* out;
    unsigned* bar;
    float *mod, *lb, *rope, *h, *kv, *filt_lat, *filt_ctx, *zb, *x0b, *of, *ob;
    bf16_t *a, *y, *u, *ckvn, *wt_ev, *wt_od, *wt_ukv, *wt_out, *wt_w1, *wt_w2;
    bf16_t *qm, *km, *vm, *qn, *kn, *vn, *p, *ckv, *kpe, *hq, *hu;
    float *he, *ssq;
    float2* kf;
    int ph_lo, ph_hi;
};

typedef const __attribute__((address_space(4))) Params* KP;
__device__ __forceinline__ KP kargs() { KP k = (KP)__builtin_amdgcn_kernarg_segment_ptr(); asm volatile("" : "+s"(k)); return k; }

constexpr size_t al256(size_t x) { return (x + 255) & ~(size_t)255; }
constexpr size_t WS_BAR   = 0;
constexpr size_t WS_MOD   = al256(WS_BAR + XCD_BAR_WORDS * 4);
constexpr size_t WS_LB    = al256(WS_MOD + (size_t)DEPTH * 5 * 6 * D * 4);
constexpr size_t WS_ROPE  = al256(WS_LB + 2 * 2 * 1024 * 4);
constexpr size_t WS_H     = al256(WS_ROPE + 64 * 16 * 2 * 4);
constexpr size_t WS_A     = al256(WS_H + (size_t)MTOT * D * 4);
constexpr size_t WS_P     = al256(WS_A + (size_t)MTOT * D * 2);
constexpr size_t WS_KV    = al256(WS_P + (size_t)MTOT * 8192 * 2);
constexpr size_t WS_CKVN  = al256(WS_KV + (size_t)MTOT * D * 4);
constexpr size_t WS_Y     = al256(WS_CKVN + (size_t)MTOT * 512 * 2);
constexpr size_t WS_U     = al256(WS_Y + (size_t)MTOT * D * 2);
constexpr size_t WS_FLAT  = al256(WS_U + (size_t)MTOT * HID * 2);
constexpr size_t WS_FCTX  = al256(WS_FLAT + (size_t)2 * 2 * SEQ * 1024 * 4);
constexpr size_t WS_ZB    = al256(WS_FCTX + (size_t)2 * 2 * CTXL * 1024 * 4);
constexpr size_t WS_X0B   = al256(WS_ZB + (size_t)MTOT * 1024 * 4);
constexpr size_t WS_OF    = al256(WS_X0B + (size_t)MTOT * 1024 * 4);
constexpr size_t WS_OB    = al256(WS_OF + (size_t)MTOT * 1024 * 4);
constexpr size_t WS_WEV   = al256(WS_OB + (size_t)MTOT * 1024 * 4);
constexpr size_t WS_WOD   = al256(WS_WEV + (size_t)2 * EVP * D * 2);
constexpr size_t WS_WUKV  = al256(WS_WOD + (size_t)2 * ODW * D * 2);
constexpr size_t WS_WOUT  = al256(WS_WUKV + (size_t)2 * D * 512 * 2);
constexpr size_t WS_WW1   = al256(WS_WOUT + (size_t)4 * D * D * 2);
constexpr size_t WS_WW2   = al256(WS_WW1 + (size_t)4 * HID * D * 2);
constexpr size_t WS_QM    = al256(WS_WW2 + (size_t)4 * D * HID * 2);
constexpr size_t WS_KM    = al256(WS_QM + (size_t)MTOT * 1536 * 2);
constexpr size_t WS_VM    = al256(WS_KM + (size_t)MTOT * 1536 * 2);
constexpr size_t WS_QN    = al256(WS_VM + (size_t)MTOT * 1024 * 2);
constexpr size_t WS_KN    = al256(WS_QN + (size_t)MTOT * 1024 * 2);
constexpr size_t WS_VN    = al256(WS_KN + (size_t)MTOT * 1024 * 2);
constexpr size_t WS_KF    = al256(WS_VN + (size_t)MTOT * 1024 * 2);
constexpr size_t WS_CKV   = al256(WS_KF + (size_t)2 * 1024 * 4096 * 8);
constexpr size_t WS_KPE   = al256(WS_CKV + (size_t)MTOT * 512 * 2);
constexpr size_t WS_HQ    = al256(WS_KPE + (size_t)MTOT * 256 * 2);
constexpr size_t WS_HU    = al256(WS_HQ + (size_t)64 * 36 * 64 * 128 * 2);
constexpr size_t WS_HE    = al256(WS_HU + (size_t)64 * 36 * 128 * 128 * 2);
constexpr size_t WS_SSQ   = al256(WS_HE + (size_t)64 * 36 * 3 * 128 * 4);
constexpr size_t WS_END   = al256(WS_SSQ + (size_t)MTOT * 8 * 4);
static_assert(WS_END <= (size_t)4 * DEPTH * D * 6 * D * 4, "workspace layout exceeds the guaranteed 4 x largest-input size");

constexpr int LDS_BYTES = 152 * 1024;
constexpr int LDS_BARW_OFF = LDS_BYTES - 16;

__device__ __forceinline__ int tid_opaque() { int t = threadIdx.x; asm volatile("" : "+v"(t)); return t; }
__device__ __forceinline__ float silu_f(float x) { return x / (1.0f + __expf(-x)); }
__device__ __forceinline__ float sigmoid_f(float x) { return 1.0f / (1.0f + __expf(-x)); }
__device__ __forceinline__ float wave_sum(float v) {
#pragma unroll
    for (int o = 32; o >= 1; o >>= 1) v += __shfl_xor(v, o);
    return v;
}
__device__ __forceinline__ int mod_row(int r) { return r < MLAT ? (r >> 11) : 4; }
typedef __bf16 bf16x2_v __attribute__((ext_vector_type(2)));
typedef float f32x2_v __attribute__((ext_vector_type(2)));
__device__ __forceinline__ unsigned cvt_pk_bf16(float lo, float hi) { const f32x2_v v = {lo, hi}; const bf16x2_v r = __builtin_convertvector(v, bf16x2_v); return __builtin_bit_cast(unsigned, r); }
__device__ __forceinline__ float bf2f(bf16_t x) { return __uint_as_float((unsigned)x << 16); }
__device__ __forceinline__ float bflo(unsigned w) { return __uint_as_float(w << 16); }
__device__ __forceinline__ float bfhi(unsigned w) { return __uint_as_float(w & 0xffff0000u); }
__device__ __forceinline__ bf16_t f2bf(float f) { return (bf16_t)(cvt_pk_bf16(f, 0.f) & 0xffffu); }

__device__ __forceinline__ void phase_prologue(KP P, float* lds) {
    const int tid = tid_opaque(), nb = gridDim.x, bid = blockIdx.x;
    if (bid == 0) {
        for (int i = tid; i < 1024; i += NTHR) {
            const int pos = i >> 4, fi = i & 15;
            const float inv = powf(10000.0f, -(float)fi / 16.0f);
            const float ang = (float)pos * inv;
            P->rope[2 * i] = cosf(ang); P->rope[2 * i + 1] = sinf(ang);
        }
    }
    if (bid == 1 % nb) {
        for (int i = tid; i < 2 * 1024; i += NTHR) {
            const int dir = i >> 10, c = i & 1023;
            const float l0 = P->lb_logits[(dir * 2 + 0) * 1024 + c], l1 = P->lb_logits[(dir * 2 + 1) * 1024 + c];
            const float mx = fmaxf(l0, l1), e0 = expf(l0 - mx), e1 = expf(l1 - mx);
            const float p1 = e1 / (e0 + e1);
            P->lb[(dir * 2 + 0) * 1024 + c] = 0.0f;
            P->lb[(dir * 2 + 1) * 1024 + c] = p1;
        }
    }
    {
        float* sv = lds;
        float* red = lds + 5 * D;
        for (int i = tid; i < 5 * D; i += NTHR) {
            const int r = i / D, k = i % D;
            const float v = r < 4 ? P->c[r * D + k] : P->c_ctx[k];
            sv[i] = silu_f(v);
        }
        __syncthreads();
        const int ng = tid & 15, ks = tid >> 4;
        for (int unit = bid; unit < DEPTH * 192; unit += nb) {
            const int l = unit / 192, n0 = (unit % 192) * 64;
            float acc[5][4];
#pragma unroll
            for (int r = 0; r < 5; ++r)
#pragma unroll
                for (int j = 0; j < 4; ++j) acc[r][j] = 0.f;
            const float* wp = P->ada_w + ((size_t)l * D + ks * 64) * (6 * D) + n0 + ng * 4;
#pragma unroll 16
            for (int k = 0; k < 64; ++k) {
                const float4 w4 = *(const float4*)(wp + (size_t)k * (6 * D));
#pragma unroll
                for (int r = 0; r < 5; ++r) {
                    const float s = sv[r * D + ks * 64 + k];
                    acc[r][0] += s * w4.x; acc[r][1] += s * w4.y; acc[r][2] += s * w4.z; acc[r][3] += s * w4.w;
                }
            }
#pragma unroll
            for (int r = 0; r < 5; ++r)
#pragma unroll
                for (int j = 0; j < 4; ++j) red[(ks * 5 + r) * 64 + ng * 4 + j] = acc[r][j];
            __syncthreads();
            if (tid < 320) {
                const int r = tid >> 6, n = tid & 63;
                float s = 0.f;
                for (int k2 = 0; k2 < 32; ++k2) s += red[(k2 * 5 + r) * 64 + n];
                P->mod[((size_t)l * 5 + r) * (6 * D) + n0 + n] = s + P->ada_b[l * 6 * D + n0 + n];
            }
            __syncthreads();
        }
    }
    {
        float* zv = lds;
        float* h1 = lds + 8 * 33;
        float* h2 = h1 + 8 * 64;
        float* h3 = h2 + 8 * 64;
        constexpr int NBL = SEQ / 8, NBC = CTXL / 8, NU = 2 * (NBL + NBC);
        const int pl = tid >> 6, j = tid & 63;
        for (int unit = bid; unit < NU; unit += nb) {
            const int o = unit / (NBL + NBC); const int rem = unit % (NBL + NBC);
            const bool isl = rem < NBL; const int n = isl ? SEQ : CTXL; const int pos0 = (isl ? rem : rem - NBL) * 8;
            __syncthreads();
            if (tid < 8 * 33) {
                const int p2 = tid / 33, i = tid % 33; const int pos = pos0 + p2;
                float v;
                if (i == 0) v = (float)pos / (float)(n - 1);
                else {
                    const int bi = (i - 1) & 15;
                    const float band = 1e-4f + (float)bi * ((15.0f - 1e-4f) / 15.0f);
                    const float ang = (float)(2.0 * 3.14159265358979323846 / (double)n) * (float)pos * band;
                    v = (i <= 16) ? cosf(ang) : -sinf(ang);
                }
                zv[p2 * 33 + i] = v;
            }
            __syncthreads();
            const float fr = P->ffreq[o * 64 + j];
            { float s = P->fb1[o * 64 + j];
              for (int i = 0; i < 33; ++i) s += zv[pl * 33 + i] * P->fw1[(o * 33 + i) * 64 + j];
              h1[pl * 64 + j] = sinf(fr * s); }
            __syncthreads();
            { float s = P->fb2[o * 64 + j];
#pragma unroll 8
              for (int i = 0; i < 64; ++i) s += h1[pl * 64 + i] * P->fw2[(o * 64 + i) * 64 + j];
              h2[pl * 64 + j] = sinf(fr * s); }
            __syncthreads();
            { float s = P->fb3[o * 64 + j];
#pragma unroll 8
              for (int i = 0; i < 64; ++i) s += h2[pl * 64 + i] * P->fw3[(o * 64 + i) * 64 + j];
              h3[pl * 64 + j] = sinf(fr * s); }
            __syncthreads();
            float acc[4][8];
#pragma unroll
            for (int q = 0; q < 4; ++q)
#pragma unroll
                for (int p2 = 0; p2 < 8; ++p2) acc[q][p2] = 0.f;
#pragma unroll 2
            for (int i = 0; i < 64; ++i) {
                float wv[4];
#pragma unroll
                for (int q = 0; q < 4; ++q) wv[q] = P->fwout[(o * 64 + i) * 2048 + tid + q * NTHR];
#pragma unroll
                for (int p2 = 0; p2 < 8; ++p2) { const float hv = h3[p2 * 64 + i];
#pragma unroll
                    for (int q = 0; q < 4; ++q) acc[q][p2] += hv * wv[q]; }
            }
#pragma unroll
            for (int q = 0; q < 4; ++q) {
                const int nn = tid + q * NTHR, dirn = nn >> 10, ch = nn & 1023;
                const float delta = 3.0701134573253944f + (float)ch * ((15.350567286626972f - 3.0701134573253944f) / 1023.0f);
#pragma unroll
                for (int p2 = 0; p2 < 8; ++p2) {
                    const int pos = pos0 + p2; const float t = (float)pos / (float)(n - 1);
                    float* dst = isl ? P->filt_lat + (((size_t)o * 2 + dirn) * SEQ + pos) * 1024 + ch
                                     : P->filt_ctx + (((size_t)o * 2 + dirn) * CTXL + pos) * 1024 + ch;
                    *dst = acc[q][p2] * expf(-t * delta);
                }
            }
        }
    }
}

__device__ __forceinline__ void phase_norm(KP P, int l, int which, int M, bool fold, bool zero_ssq) {
    const int tid = tid_opaque(), lane = tid & 63, w = tid >> 6;
    (void)zero_ssq;
    const float* g = (which == 0 ? P->norm_mix_g : P->norm_mlp_g) + l * D;
    for (int row = blockIdx.x * 8 + w; row < M; row += gridDim.x * 8) {
        float* hr = P->h + (size_t)row * D;
        const float* hs = (l == 0 && (which == 0 || row >= MLAT)) ? (row < MLAT ? P->x + (size_t)row * D : P->ctx + (size_t)(row - MLAT) * D) : hr;
        float4 v[8]; float ss = 0.f;
#pragma unroll
        for (int i = 0; i < 8; ++i) v[i] = *(const float4*)(hs + i * 256 + lane * 4);
        if (fold && row >= MLAT) {
            const float* sl = P->kv + (size_t)(row - MLAT) * D;
#pragma unroll
            for (int ks = 0; ks < 8; ++ks)
#pragma unroll
                for (int i = 0; i < 8; ++i) { const float4 a = *(const float4*)(sl + (size_t)ks * MCTX * D + i * 256 + lane * 4); v[i].x += a.x; v[i].y += a.y; v[i].z += a.z; v[i].w += a.w; }
#pragma unroll
            for (int i = 0; i < 8; ++i) *(float4*)(hr + i * 256 + lane * 4) = v[i];
        }
#pragma unroll
        for (int i = 0; i < 8; ++i) ss += v[i].x * v[i].x + v[i].y * v[i].y + v[i].z * v[i].z + v[i].w * v[i].w;
        ss = wave_sum(ss);
        const float rstd = rsqrtf(ss * (1.0f / D) + NORM_EPS);
        const float* mr = P->mod + ((size_t)l * 5 + mod_row(row)) * (6 * D) + (which == 0 ? 0 : 3 * D);
        bf16_t* ar = P->a + (size_t)row * D;
#pragma unroll
        for (int i = 0; i < 8; ++i) {
            const int col = i * 256 + lane * 4;
            const float4 gg = *(const float4*)(g + col), sh = *(const float4*)(mr + col), sc = *(const float4*)(mr + D + col);
            float4 o;
            o.x = v[i].x * rstd * gg.x * (1.0f + sc.x) + sh.x;
            o.y = v[i].y * rstd * gg.y * (1.0f + sc.y) + sh.y;
            o.z = v[i].z * rstd * gg.z * (1.0f + sc.z) + sh.z;
            o.w = v[i].w * rstd * gg.w * (1.0f + sc.w) + sh.w;
            uint2 pk; pk.x = cvt_pk_bf16(o.x, o.y); pk.y = cvt_pk_bf16(o.z, o.w);
            *(uint2*)(ar + col) = pk;
        }
    }
}

namespace pg8 {
#define PG8_LAS __attribute__((address_space(3)))
typedef short bf16x8 __attribute__((ext_vector_type(8)));
typedef float f32x4 __attribute__((ext_vector_type(4)));
typedef unsigned u32x4 __attribute__((ext_vector_type(4)));
constexpr int BM = 256, BK = 64, HALF = 128, HTB = HALF * BK * 2, STAGE_BYTES = 8 * HTB, NXCD = 8, WGM = 8;
__host__ __device__ __forceinline__ int lds_byte(int r, int c) { const int st = (r >> 4) * 2 + (c >> 5), rr = r & 15, cc = c & 31, ob = rr * 64 + cc * 2; return st * 1024 + (ob ^ (((ob >> 9) & 1) << 5)); }
__host__ __device__ __forceinline__ void stage_rc(int b, int& R, int& C) { const int st = b / 1024, sb = b % 1024, swz = sb ^ (((sb >> 9) & 1) << 5); R = (st >> 1) * 16 + swz / 64; C = (st & 1) * 32 + (swz % 64) / 2; }
__host__ __device__ __forceinline__ int perm32(int rho) { const int n = rho >> 4, i = rho & 15; return 8 * (i >> 2) + 4 * n + (i & 3); }
struct Unit { int pm, pn, k0, nk, atomic; };
struct Gemm { const bf16_t* A; const bf16_t* Bt; int M, N, K; };
struct StaticOrder {
    int nM, nN, nwg, G, c, ntk;
    __host__ __device__ void init(int M, int N, int K, int G_, int c_) { nM = M / BM; nN = N / BM; nwg = nM * nN; G = G_; c = c_; ntk = K / BK; }
    __host__ __device__ bool next(int i, Unit& u) const {
        const long L = (long)i * G + c; if (L >= nwg) return false;
        int wgid = (int)L; { const int q = nwg / NXCD, r = nwg % NXCD, xcd = wgid % NXCD, off = wgid / NXCD; wgid = (xcd < r ? xcd * (q + 1) : r * (q + 1) + (xcd - r) * q) + off; }
        const int nig = WGM * nN, gid = wgid / nig, fm = gid * WGM, gsz = (nM - fm) < WGM ? (nM - fm) : WGM;
        u.pm = fm + ((wgid % nig) % gsz); u.pn = (wgid % nig) / gsz; u.k0 = 0; u.nk = ntk; u.atomic = 0; return true;
    }
    __device__ __forceinline__ void a_ready(const Unit&) const {}
    __device__ __forceinline__ void done(const Unit&) const {}
};
struct SplitOrder {
    StaticOrder lat; int G, c, nsub, ntk, nN;
    __host__ __device__ void init(int M, int N, int K, int G_, int c_) { lat.init(MLAT, N, K, G_, c_); G = G_; c = c_; ntk = K / BK; nN = N / BM; nsub = M > MLAT ? ((M - MLAT) / BM) * nN * 8 : 0; }
    __host__ __device__ bool next(int i, Unit& u) const {
        const long L = (long)i * G + c;
        if (L < lat.nwg) return lat.next(i, u);
        const int j = (int)(L - lat.nwg); if (j >= nsub) return false;
        const int ct = j >> 3, ks = j & 7;
        u.pm = MLAT / BM + ct / nN; u.pn = ct % nN; u.k0 = ks * (ntk / 8); u.nk = ntk / 8; u.atomic = 1; return true;
    }
    __device__ __forceinline__ void a_ready(const Unit&) const {}
    __device__ __forceinline__ void done(const Unit&) const {}
};
template <class Epi, class Sched>
__device__ __forceinline__ void gemm_phase(PG8_LAS unsigned char* lds, const Gemm g, const Sched& S, const Epi& E) {
    const int tid = tid_opaque(), wid = __builtin_amdgcn_readfirstlane(tid >> 6), lane = tid & 63, wr = wid >> 2, wc = wid & 3, fr = lane & 15, fq = lane >> 4;
    const int K = g.K;
    unsigned voffA[2], voffB[2];
#pragma unroll
    for (int i = 0; i < 2; ++i) { int R, C; stage_rc(tid * 16 + i * 8192, R, C); const int Rb = Epi::PERM ? ((R & ~31) + perm32(R & 31)) : R;
        voffA[i] = (unsigned)(R * K + C) * 2u; voffB[i] = (unsigned)(Rb * K + C) * 2u; }
    const size_t kstep = (size_t)(BK * 2);
    const size_t hstep = (size_t)HALF * K * 2;
    const size_t tstep = 2 * hstep;
    const unsigned ldsw = (unsigned)wid * 1024u;
    const int aoff = lds_byte(wr * 64 + fr, fq * 8), boff = lds_byte(wc * 32 + fr, fq * 8);
#define PG8_SA(b, h) (((b) * 2 + (h)) * HTB)
#define PG8_SB(b, h) ((4 + (b) * 2 + (h)) * HTB)
#define PG8_STAGE(bufoff, gbase, voff) do { _Pragma("unroll") for (int _i = 0; _i < 2; ++_i) \
        __builtin_amdgcn_global_load_lds((const unsigned*)((const char*)(gbase) + (voff)[_i]), (PG8_LAS unsigned*)(lds + (bufoff) + ldsw + _i * 8192), 16, 0, 0); } while (0)
#define PG8_LDA(dst, b, h) do { _Pragma("unroll") for (int m = 0; m < 4; ++m) _Pragma("unroll") for (int k = 0; k < 2; ++k) dst[m][k] = *(const PG8_LAS bf16x8*)(lds + PG8_SA(b, h) + aoff + m * 2048 + k * 1024); } while (0)
#define PG8_LDB(dst, b, h) do { _Pragma("unroll") for (int n = 0; n < 2; ++n) _Pragma("unroll") for (int k = 0; k < 2; ++k) dst[n][k] = *(const PG8_LAS bf16x8*)(lds + PG8_SB(b, h) + boff + n * 2048 + k * 1024); } while (0)
#define PG8_MMA(ai, bj, At, Bt) do { __builtin_amdgcn_s_setprio(1); _Pragma("unroll") for (int m = 0; m < 4; ++m) _Pragma("unroll") for (int n = 0; n < 2; ++n) _Pragma("unroll") for (int k = 0; k < 2; ++k) \
        acc[ai][bj][m][n] = __builtin_amdgcn_mfma_f32_16x16x32_bf16(Bt[n][k], At[m][k], acc[ai][bj][m][n], 0, 0, 0); __builtin_amdgcn_s_setprio(0); } while (0)
#define PG8_WAIT_V(n) asm volatile("s_waitcnt vmcnt(" #n ")" ::: "memory")
#define PG8_WAIT_L(n) asm volatile("s_waitcnt lgkmcnt(" #n ")" ::: "memory")
#define PG8_BAR __builtin_amdgcn_s_barrier()
#define PG8_SCHED __builtin_amdgcn_sched_barrier(0)
    Unit cur, nxt; int ui = 0;
    if (!S.next(0, cur)) return;
    f32x4 acc[2][2][4][2];
#pragma unroll
    for (int a = 0; a < 2; ++a)
#pragma unroll
        for (int b = 0; b < 2; ++b)
#pragma unroll
            for (int m = 0; m < 4; ++m)
#pragma unroll
                for (int n = 0; n < 2; ++n) acc[a][b][m][n] = (f32x4){0.f, 0.f, 0.f, 0.f};
    bf16x8 At[4][2], B0[2][2], B1[2][2];
    const char* cA = (const char*)g.A + (size_t)cur.pm * tstep + (size_t)cur.k0 * kstep; const char* cB = (const char*)g.Bt + (size_t)cur.pn * tstep + (size_t)cur.k0 * kstep;
    S.a_ready(cur);
    PG8_STAGE(PG8_SB(0, 0), cB, voffB); PG8_STAGE(PG8_SA(0, 0), cA, voffA); PG8_STAGE(PG8_SB(0, 1), cB + hstep, voffB); PG8_STAGE(PG8_SA(0, 1), cA + hstep, voffA);
    if (wr == 1) PG8_BAR;
    PG8_WAIT_V(4); PG8_BAR;
    PG8_STAGE(PG8_SB(1, 0), cB + kstep, voffB); PG8_STAGE(PG8_SA(1, 0), cA + kstep, voffA); PG8_STAGE(PG8_SB(1, 1), cB + hstep + kstep, voffB);
    PG8_WAIT_V(6); PG8_BAR;
    for (;;) {
        const bool has_next = S.next(ui + 1, nxt);
        const char* nA = has_next ? (const char*)g.A + (size_t)nxt.pm * tstep + (size_t)nxt.k0 * kstep : cA; const char* nB = has_next ? (const char*)g.Bt + (size_t)nxt.pn * tstep + (size_t)nxt.k0 * kstep : cB;
        const int nt = cur.nk;
        for (int t = 0; t < nt; t += 2) {
            const bool last = (t == nt - 2);
            const char* a1 = cA + (size_t)(t + 1) * kstep;
            const char* a2 = last ? nA : cA + (size_t)(t + 2) * kstep; const char* b2 = last ? nB : cB + (size_t)(t + 2) * kstep;
            const char* a3 = a2 + kstep; const char* b3 = b2 + kstep;
            if (last && has_next) S.a_ready(nxt);
            PG8_LDB(B0, 0, 0); PG8_SCHED; PG8_LDA(At, 0, 0); PG8_STAGE(PG8_SA(1, 1), a1 + hstep, voffA);
            PG8_WAIT_L(8); PG8_BAR; PG8_WAIT_L(0); PG8_MMA(0, 0, At, B0); PG8_BAR; PG8_SCHED;
            PG8_LDB(B1, 0, 1); PG8_STAGE(PG8_SB(0, 0), b2, voffB);
            PG8_BAR; PG8_WAIT_L(0); PG8_MMA(0, 1, At, B1); PG8_BAR;
            PG8_LDA(At, 0, 1); PG8_STAGE(PG8_SA(0, 0), a2, voffA);
            PG8_BAR; PG8_WAIT_L(0); PG8_MMA(1, 0, At, B0); PG8_BAR; PG8_SCHED;
            PG8_STAGE(PG8_SB(0, 1), b2 + hstep, voffB);
            PG8_WAIT_V(6); PG8_BAR; PG8_MMA(1, 1, At, B1); PG8_BAR;
            PG8_LDB(B0, 1, 0); PG8_SCHED; PG8_LDA(At, 1, 0); PG8_STAGE(PG8_SA(0, 1), a2 + hstep, voffA);
            PG8_WAIT_L(8); PG8_BAR; PG8_WAIT_L(0); PG8_MMA(0, 0, At, B0); PG8_BAR; PG8_SCHED;
            PG8_LDB(B1, 1, 1); PG8_STAGE(PG8_SB(1, 0), b3, voffB);
            PG8_BAR; PG8_WAIT_L(0); PG8_MMA(0, 1, At, B1); PG8_BAR;
            PG8_LDA(At, 1, 1); PG8_STAGE(PG8_SA(1, 0), a3, voffA);
            PG8_BAR; PG8_WAIT_L(0); PG8_MMA(1, 0, At, B0); PG8_BAR; PG8_SCHED;
            PG8_STAGE(PG8_SB(1, 1), b3 + hstep, voffB);
            PG8_WAIT_V(6); PG8_BAR; PG8_MMA(1, 1, At, B1); PG8_BAR;
        }
        E(acc, cur, wr, wc, fr, fq); S.done(cur);
        if (!has_next) break;
#pragma unroll
        for (int a = 0; a < 2; ++a)
#pragma unroll
            for (int b = 0; b < 2; ++b)
#pragma unroll
                for (int m = 0; m < 4; ++m)
#pragma unroll
                    for (int n = 0; n < 2; ++n) acc[a][b][m][n] = (f32x4){0.f, 0.f, 0.f, 0.f};
        cur = nxt; cA = nA; cB = nB; ++ui;
    }
    PG8_WAIT_V(0);
    if (wr == 0) PG8_BAR;
    PG8_BAR;
#undef PG8_SA
#undef PG8_SB
#undef PG8_STAGE
#undef PG8_LDA
#undef PG8_LDB
#undef PG8_MMA
#undef PG8_WAIT_V
#undef PG8_WAIT_L
#undef PG8_BAR
#undef PG8_SCHED
}
}

struct EpiStoreF32 {
    static constexpr bool PERM = false;
    float* C; int ldc;
    __device__ __forceinline__ void operator()(const pg8::f32x4 (&acc)[2][2][4][2], const pg8::Unit& u, int wr, int wc, int fr, int fq) const {
        const int row0 = u.pm * 256 + wr * 64 + fr, col0 = u.pn * 256 + wc * 32 + 4 * fq;
#pragma unroll
        for (int ai = 0; ai < 2; ++ai)
#pragma unroll
            for (int m = 0; m < 4; ++m) { float* rowp = C + (size_t)(row0 + ai * 128 + m * 16) * ldc + col0;
#pragma unroll
                for (int bj = 0; bj < 2; ++bj)
#pragma unroll
                    for (int n = 0; n < 2; ++n) *(pg8::f32x4*)(rowp + bj * 128 + n * 16) = acc[ai][bj][m][n]; }
    }
};
struct EpiResid {
    static constexpr bool PERM = false;
    float* h; const float* gate; float* slab; const float* hin;
    __device__ __forceinline__ void operator()(const pg8::f32x4 (&acc)[2][2][4][2], const pg8::Unit& u, int wr, int wc, int fr, int fq) const {
        const int row0 = u.pm * 256 + wr * 64 + fr, col0 = u.pn * 256 + wc * 32 + 4 * fq;
#pragma unroll
        for (int ai = 0; ai < 2; ++ai)
#pragma unroll
            for (int m = 0; m < 4; ++m) { const int row = row0 + ai * 128 + m * 16; float* rowp = h + (size_t)row * D + col0; const float* gp = gate + (size_t)mod_row(row) * (6 * D) + col0;
#pragma unroll
                for (int bj = 0; bj < 2; ++bj)
#pragma unroll
                    for (int n = 0; n < 2; ++n) { const pg8::f32x4 gt = *(const pg8::f32x4*)(gp + bj * 128 + n * 16); const pg8::f32x4 v = gt * acc[ai][bj][m][n]; float* q = rowp + bj * 128 + n * 16;
                        if (u.atomic) { *(pg8::f32x4*)(slab + ((size_t)(u.k0 / u.nk) * MCTX + (row - MLAT)) * D + col0 + bj * 128 + n * 16) = v; }
                        else { const pg8::f32x4 hv = *(const pg8::f32x4*)(hin + (size_t)row * D + col0 + bj * 128 + n * 16); *(pg8::f32x4*)q = hv + v; } } }
    }
};
struct EpiRelu2Bf16 {
    static constexpr bool PERM = true;
    bf16_t* O; int ldc;
    __device__ __forceinline__ void operator()(const pg8::f32x4 (&acc)[2][2][4][2], const pg8::Unit& u, int wr, int wc, int fr, int fq) const {
        const int row0 = u.pm * 256 + wr * 64 + fr, col0 = u.pn * 256 + wc * 32 + 8 * fq;
#pragma unroll
        for (int ai = 0; ai < 2; ++ai)
#pragma unroll
            for (int m = 0; m < 4; ++m) { bf16_t* rowp = O + (size_t)(row0 + ai * 128 + m * 16) * ldc + col0;
#pragma unroll
                for (int bj = 0; bj < 2; ++bj) { pg8::f32x4 v0 = acc[ai][bj][m][0], v1 = acc[ai][bj][m][1];
#pragma unroll
                    for (int j = 0; j < 4; ++j) { const float a0 = fmaxf(v0[j], 0.f), a1 = fmaxf(v1[j], 0.f); v0[j] = a0 * a0; v1[j] = a1 * a1; }
                    pg8::u32x4 w; w.x = cvt_pk_bf16(v0[0], v0[1]); w.y = cvt_pk_bf16(v0[2], v0[3]); w.z = cvt_pk_bf16(v1[0], v1[1]); w.w = cvt_pk_bf16(v1[2], v1[3]);
                    *(pg8::u32x4*)(rowp + bj * 128) = w; } }
    }
};
template <class F> __device__ __forceinline__ void epi_bf16_rows(const pg8::f32x4 (&acc)[2][2][4][2], int row0, const F& dst) {
#pragma unroll
    for (int ai = 0; ai < 2; ++ai)
#pragma unroll
        for (int m = 0; m < 4; ++m) { const int row = row0 + ai * 128 + m * 16;
#pragma unroll
            for (int bj = 0; bj < 2; ++bj) { const pg8::f32x4 v0 = acc[ai][bj][m][0], v1 = acc[ai][bj][m][1];
                pg8::u32x4 w; w.x = cvt_pk_bf16(v0[0], v0[1]); w.y = cvt_pk_bf16(v0[2], v0[3]); w.z = cvt_pk_bf16(v1[0], v1[1]); w.w = cvt_pk_bf16(v1[2], v1[3]);
                *(pg8::u32x4*)dst(row, bj) = w; } }
}
struct EpiStoreBf16 {
    static constexpr bool PERM = true;
    bf16_t* O; int ldc;
    __device__ __forceinline__ void operator()(const pg8::f32x4 (&acc)[2][2][4][2], const pg8::Unit& u, int wr, int wc, int fr, int fq) const {
        const int col0 = u.pn * 256 + wc * 32 + 8 * fq; bf16_t* O_ = O; const int ldc_ = ldc;
        epi_bf16_rows(acc, u.pm * 256 + wr * 64 + fr, [=](int row, int bj) { return O_ + (size_t)row * ldc_ + col0 + bj * 128; });
    }
};
struct EpiEvenRoute {
    static constexpr bool PERM = true;
    bf16_t *qm, *ckv, *qn, *kn, *vn, *kpe; float* ssq;
    __device__ __forceinline__ void operator()(const pg8::f32x4 (&acc)[2][2][4][2], const pg8::Unit& u, int wr, int wc, int fr, int fq) const {
        const int pn = u.pn; bf16_t* base; int ldc, colt;
        if (pn < 6) { base = qm; ldc = 1536; colt = pn * 256; } else if (pn < 8) { base = ckv; ldc = 512; colt = (pn - 6) * 256; }
        else if (pn < 12) { base = qn; ldc = 1024; colt = (pn - 8) * 256; } else if (pn < 16) { base = kn; ldc = 1024; colt = (pn - 12) * 256; }
        else if (pn < 20) { base = vn; ldc = 1024; colt = (pn - 16) * 256; } else { base = kpe; ldc = 256; colt = 0; }
        const int col0 = colt + wc * 32 + 8 * fq;
        epi_bf16_rows(acc, u.pm * 256 + wr * 64 + fr, [=](int row, int bj) { return base + (size_t)row * ldc + col0 + bj * 128; });
        if (pn == 6 || pn == 7) {
#pragma unroll
            for (int ai = 0; ai < 2; ++ai)
#pragma unroll
                for (int m = 0; m < 4; ++m) { float q = 0.f;
#pragma unroll
                    for (int bj = 0; bj < 2; ++bj)
#pragma unroll
                        for (int n = 0; n < 2; ++n) { const pg8::f32x4 x = acc[ai][bj][m][n]; q += (x[0] * x[0] + x[1] * x[1]) + (x[2] * x[2] + x[3] * x[3]); }
                    q += __shfl_xor(q, 16); q += __shfl_xor(q, 32);
                    if (fq == 0) ssq[(size_t)(u.pm * 256 + wr * 64 + fr + ai * 128 + m * 16) * 8 + (pn - 6) * 4 + wc] = q; }
        }
    }
};
struct EpiKV {
    static constexpr bool PERM = true;
    bf16_t *km, *vm; const float* ssq;
    __device__ __forceinline__ void operator()(const pg8::f32x4 (&acc)[2][2][4][2], const pg8::Unit& u, int wr, int wc, int fr, int fq) const {
        const int cw = wc * 32 + 8 * fq, row0 = u.pm * 256 + wr * 64 + fr; bf16_t* kb = km + u.pn * 192 + cw; bf16_t* vb = vm + u.pn * 128 + cw;
#pragma unroll
        for (int ai = 0; ai < 2; ++ai)
#pragma unroll
            for (int m = 0; m < 4; ++m) { const int row = row0 + ai * 128 + m * 16; const pg8::f32x4 sa = *(const pg8::f32x4*)(ssq + (size_t)row * 8), sb = *(const pg8::f32x4*)(ssq + (size_t)row * 8 + 4);
                const float rs = rsqrtf((((sa[0] + sa[1]) + (sa[2] + sa[3])) + ((sb[0] + sb[1]) + (sb[2] + sb[3]))) * (1.0f / 512.0f) + NORM_EPS);
#pragma unroll
                for (int bj = 0; bj < 2; ++bj) { const pg8::f32x4 v0 = acc[ai][bj][m][0] * rs, v1 = acc[ai][bj][m][1] * rs;
                    pg8::u32x4 w; w.x = cvt_pk_bf16(v0[0], v0[1]); w.y = cvt_pk_bf16(v0[2], v0[3]); w.z = cvt_pk_bf16(v1[0], v1[1]); w.w = cvt_pk_bf16(v1[2], v1[3]);
                    *(pg8::u32x4*)(bj == 0 ? kb + (size_t)row * 1536 : vb + (size_t)row * 1024) = w; } }
    }
};
template <class Epi> __device__ __forceinline__ void run_gemm(LAS unsigned char* lds, const bf16_t* A, const bf16_t* Bt, int M, int N, int K, const Epi& E) {
    pg8::Gemm g{A, Bt, M, N, K}; pg8::StaticOrder S; S.init(M, N, K, (int)gridDim.x, (int)blockIdx.x);
    pg8::gemm_phase<Epi, pg8::StaticOrder>(lds, g, S, E);
}
template <class Epi> __device__ __forceinline__ void run_gemm_split(LAS unsigned char* lds, const bf16_t* A, const bf16_t* Bt, int M, int N, int K, const Epi& E) {
    pg8::Gemm g{A, Bt, M, N, K}; pg8::SplitOrder S; S.init(M, N, K, (int)gridDim.x, (int)blockIdx.x);
    pg8::gemm_phase<Epi, pg8::SplitOrder>(lds, g, S, E);
}

struct WtTile { const float* W; bf16_t* Wt; const float* rs; int K, N, k0, n0, ns; };
__device__ __forceinline__ WtTile wt_tile(KP P, int unit) {
    WtTile r; int t; r.rs = nullptr;
    if (unit < 1344)      { const int j = unit / 672;          t = unit % 672;           r.W = P->ev_w_in + (size_t)j * D * EVW; r.Wt = P->wt_ev + (size_t)j * EVP * D; r.K = D; r.N = EVW; }
    else if (unit < 3392) { const int j = (unit - 1344) / 1024; t = (unit - 1344) % 1024; r.W = P->od_w_in + (size_t)j * D * ODW; r.Wt = P->wt_od + (size_t)j * ODW * D; r.K = D; r.N = ODW; }
    else if (unit < 3520) { const int j = (unit - 3392) / 64;   t = (unit - 3392) % 64;   r.W = P->w_ukv + (size_t)j * 512 * D;   r.Wt = P->wt_ukv + (size_t)j * D * 512;  r.K = 512; r.N = D; r.rs = P->kv_norm_g + j * 512; }
    else if (unit < 4544) { const int j = (unit - 3520) / 256;  t = (unit - 3520) % 256;  r.W = P->w_out + (size_t)j * D * D;     r.Wt = P->wt_out + (size_t)j * D * D;    r.K = D; r.N = D; }
    else if (unit < 8640) { const int j = (unit - 4544) / 1024; t = (unit - 4544) % 1024; r.W = P->mlp_w1 + (size_t)j * D * HID;  r.Wt = P->wt_w1 + (size_t)j * HID * D;   r.K = D; r.N = HID; }
    else                  { const int j = (unit - 8640) / 1024; t = (unit - 8640) % 1024; r.W = P->mlp_w2 + (size_t)j * HID * D;  r.Wt = P->wt_w2 + (size_t)j * D * HID;   r.K = HID; r.N = D; }
    const int nkt = r.K / 256; r.k0 = (t % nkt) * 256; r.n0 = (t / nkt) * 64;
    r.ns = r.n0; if (unit < 1344) r.ns = r.n0 < 2048 ? r.n0 : (r.n0 < 5120 ? r.n0 + 64 : (r.n0 < 5184 ? r.n0 - 5120 + 2048 : r.N));
    return r;
}
__device__ __forceinline__ void phase_convert_weights(KP P, float* ldsf) {
    unsigned* T = (unsigned*)ldsf;
    const int tid = tid_opaque();
    constexpr int NTILES = 12736;
    float4 r0[4], r1[4];
#define WT_LOAD(u_) do { const WtTile q_ = wt_tile(P, (u_)); _Pragma("unroll") for (int i = 0; i < 4; ++i) { const int idx = tid + i * NTHR, c4 = idx & 15, kp = idx >> 4; \
        if (q_.ns + c4 * 4 < q_.N) { const float* src = q_.W + (size_t)(q_.k0 + 2 * kp) * q_.N + q_.ns + c4 * 4; r0[i] = *(const float4*)src; r1[i] = *(const float4*)(src + q_.N); \
            if (q_.rs) { const float g0_ = q_.rs[q_.k0 + 2 * kp], g1_ = q_.rs[q_.k0 + 2 * kp + 1]; r0[i].x *= g0_; r0[i].y *= g0_; r0[i].z *= g0_; r0[i].w *= g0_; r1[i].x *= g1_; r1[i].y *= g1_; r1[i].z *= g1_; r1[i].w *= g1_; } } \
        else { r0[i] = make_float4(0.f, 0.f, 0.f, 0.f); r1[i] = r0[i]; } } } while (0)
    int unit = blockIdx.x;
    if (unit < NTILES) WT_LOAD(unit);
    for (; unit < NTILES; unit += gridDim.x) {
        __syncthreads();
#pragma unroll
        for (int i = 0; i < 4; ++i) {
            const int idx = tid + i * NTHR, c4 = idx & 15, kp = idx >> 4;
            T[(c4 * 4 + 0) * 129 + kp] = cvt_pk_bf16(r0[i].x, r1[i].x);
            T[(c4 * 4 + 1) * 129 + kp] = cvt_pk_bf16(r0[i].y, r1[i].y);
            T[(c4 * 4 + 2) * 129 + kp] = cvt_pk_bf16(r0[i].z, r1[i].z);
            T[(c4 * 4 + 3) * 129 + kp] = cvt_pk_bf16(r0[i].w, r1[i].w);
        }
        if (unit + (int)gridDim.x < NTILES) WT_LOAD(unit + (int)gridDim.x);
        __syncthreads();
        const WtTile q = wt_tile(P, unit);
#pragma unroll
        for (int i = 0; i < 4; ++i) {
            const int idx = tid + i * NTHR, kc = idx & 31, n = idx >> 5;
            uint4 w; w.x = T[n * 129 + kc * 4 + 0]; w.y = T[n * 129 + kc * 4 + 1]; w.z = T[n * 129 + kc * 4 + 2]; w.w = T[n * 129 + kc * 4 + 3];
            *(uint4*)(q.Wt + (size_t)(q.n0 + n) * q.K + q.k0 + kc * 8) = w;
        }
    }
#undef WT_LOAD
}

__device__ __forceinline__ void phase_ckvnorm(KP P, int e) {
    const int tid = tid_opaque(), lane = tid & 63, w = tid >> 6;
    const float* g = P->kv_norm_g + e * 512;
    for (int row = blockIdx.x * 8 + w; row < MTOT; row += gridDim.x * 8) {
        const uint4 x = *(const uint4*)(P->ckv + (size_t)row * 512 + lane * 8);
        float v[8] = {bflo(x.x), bfhi(x.x), bflo(x.y), bfhi(x.y), bflo(x.z), bfhi(x.z), bflo(x.w), bfhi(x.w)};
        float ss = 0.f;
#pragma unroll
        for (int j = 0; j < 8; ++j) ss += v[j] * v[j];
        ss = wave_sum(ss);
        const float rstd = rsqrtf(ss * (1.0f / 512.0f) + NORM_EPS);
        const float4 g0 = *(const float4*)(g + lane * 8), g1 = *(const float4*)(g + lane * 8 + 4);
        uint4 o; o.x = cvt_pk_bf16(v[0] * rstd * g0.x, v[1] * rstd * g0.y); o.y = cvt_pk_bf16(v[2] * rstd * g0.z, v[3] * rstd * g0.w);
        o.z = cvt_pk_bf16(v[4] * rstd * g1.x, v[5] * rstd * g1.y); o.w = cvt_pk_bf16(v[6] * rstd * g1.z, v[7] * rstd * g1.w);
        *(uint4*)(P->ckvn + (size_t)row * 512 + lane * 8) = o;
    }
}
__device__ __forceinline__ void rope_pair(const bf16_t* src, int dd, int pos, const float* rope, bool lat, uint4& oa, uint4& ob) {
    const uint4 xa = *(const uint4*)(src + dd), xb = *(const uint4*)(src + dd + 16);
    if (!lat) { oa = xa; ob = xb; return; }
    const float a[8] = {bflo(xa.x), bfhi(xa.x), bflo(xa.y), bfhi(xa.y), bflo(xa.z), bfhi(xa.z), bflo(xa.w), bfhi(xa.w)};
    const float b[8] = {bflo(xb.x), bfhi(xb.x), bflo(xb.y), bfhi(xb.y), bflo(xb.z), bfhi(xb.z), bflo(xb.w), bfhi(xb.w)};
    float ra[8], rb[8]; const int i0 = dd & 15;
#pragma unroll
    for (int j = 0; j < 8; ++j) { const float cs = rope[(pos * 16 + i0 + j) * 2], sn = rope[(pos * 16 + i0 + j) * 2 + 1]; ra[j] = a[j] * cs - b[j] * sn; rb[j] = b[j] * cs + a[j] * sn; }
    oa.x = cvt_pk_bf16(ra[0], ra[1]); oa.y = cvt_pk_bf16(ra[2], ra[3]); oa.z = cvt_pk_bf16(ra[4], ra[5]); oa.w = cvt_pk_bf16(ra[6], ra[7]);
    ob.x = cvt_pk_bf16(rb[0], rb[1]); ob.y = cvt_pk_bf16(rb[2], rb[3]); ob.z = cvt_pk_bf16(rb[4], rb[5]); ob.w = cvt_pk_bf16(rb[6], rb[7]);
}
__device__ __forceinline__ void phase_rope_fix(KP P) {
    const size_t total = (size_t)MTOT * 36;
    for (size_t it = (size_t)blockIdx.x * NTHR + tid_opaque(); it < total; it += (size_t)gridDim.x * NTHR) {
        const int row = (int)(it / 36), c = (int)(it % 36);
        const bool lat = row < MLAT; const int tpos = row & (SEQ - 1), grow = tpos >> 6, gcol = tpos & 63;
        const int q4 = c & 3, dd = (q4 >> 1) * 32 + (q4 & 1) * 8, pos = (q4 >> 1) ? gcol : grow;
        uint4 oa, ob;
        if (c < 32) {
            if (!lat) continue;
            bf16_t* v = P->qm + (size_t)row * 1536 + (c >> 2) * 192 + 128;
            rope_pair(v, dd, pos, P->rope, true, oa, ob);
            *(uint4*)(v + dd) = oa; *(uint4*)(v + dd + 16) = ob;
        } else {
            rope_pair(P->kpe + (size_t)row * 256, dd, pos, P->rope, lat, oa, ob);
            bf16_t* k = P->km + (size_t)row * 1536 + 128;
#pragma unroll
            for (int hh = 0; hh < 8; ++hh) { *(uint4*)(k + hh * 192 + dd) = oa; *(uint4*)(k + hh * 192 + dd + 16) = ob; }
        }
    }
}

namespace att {
typedef short bf16x8 __attribute__((ext_vector_type(8)));
typedef short s16x4 __attribute__((ext_vector_type(4)));
typedef float f32x16 __attribute__((ext_vector_type(16)));
typedef unsigned u32x4 __attribute__((ext_vector_type(4)));
constexpr int SHM_V = 64 * 128 * 2;
#define ATT_SBAR() __builtin_amdgcn_sched_barrier(0)
__device__ __forceinline__ int crow(int r, int hi) { return (r & 3) + 8 * (r >> 2) + 4 * hi; }
__device__ __forceinline__ unsigned cvtpk(float lo, float hi) { return cvt_pk_bf16(lo, hi); }
__device__ __forceinline__ void partialSM(f32x16& p0, f32x16& p1, float& m_reg, float& mn, float& alpha, const float C, const float thr_raw) {
  float pmax = p0[0];
#pragma unroll
  for (int r = 1; r < 16; ++r) pmax = fmaxf(pmax, p0[r]);
#pragma unroll
  for (int r = 0; r < 16; ++r) pmax = fmaxf(pmax, p1[r]);
  { auto rr = __builtin_amdgcn_permlane32_swap(__float_as_uint(pmax), __float_as_uint(pmax), false, false);
    pmax = fmaxf(__uint_as_float(rr[0]), __uint_as_float(rr[1])); }
  if (__builtin_expect(__all(pmax - m_reg <= thr_raw), 1)) { mn = m_reg; alpha = 1.f; }
  else { mn = fmaxf(m_reg, pmax); alpha = __builtin_amdgcn_exp2f((m_reg - mn) * C); m_reg = mn; }
  const float mnC = -mn * C;
#pragma unroll
  for (int r = 0; r < 16; ++r) p0[r] = fmaf(p0[r], C, mnC);
#pragma unroll
  for (int r = 0; r < 16; ++r) p1[r] = fmaf(p1[r], C, mnC);
#pragma unroll
  for (int r = 0; r < 16; ++r) p0[r] = __builtin_amdgcn_exp2f(p0[r]);
}
__device__ __forceinline__ void finishSM(f32x16& p0, f32x16& p1, float alpha, float& l_reg, bf16x8& pa0, bf16x8& pa1, bf16x8& pa2, bf16x8& pa3) {
#pragma unroll
  for (int r = 0; r < 16; ++r) p1[r] = __builtin_amdgcn_exp2f(p1[r]);
  float ps = 0;
#pragma unroll
  for (int r = 0; r < 16; ++r) ps += p0[r];
#pragma unroll
  for (int r = 0; r < 16; ++r) ps += p1[r];
  { auto rr = __builtin_amdgcn_permlane32_swap(__float_as_uint(ps), __float_as_uint(ps), false, false);
    ps = __uint_as_float(rr[0]) + __uint_as_float(rr[1]); }
  l_reg = l_reg * alpha + ps;
#define ATT_PK4(P, BASE, OUT) do { unsigned a0 = cvtpk(P[BASE + 0], P[BASE + 1]), a1 = cvtpk(P[BASE + 2], P[BASE + 3]);   \
    unsigned b0 = cvtpk(P[BASE + 4], P[BASE + 5]), b1 = cvtpk(P[BASE + 6], P[BASE + 7]);                              \
    auto r0 = __builtin_amdgcn_permlane32_swap(a0, b0, false, false); auto r1 = __builtin_amdgcn_permlane32_swap(a1, b1, false, false); \
    u32x4 w = {r0[0], r1[0], r0[1], r1[1]}; OUT = *reinterpret_cast<bf16x8*>(&w); } while (0)
  ATT_PK4(p0, 0, pa0); ATT_PK4(p0, 8, pa1); ATT_PK4(p1, 0, pa2); ATT_PK4(p1, 8, pa3);
#undef ATT_PK4
}
template <int DQK> __device__ __forceinline__ int kswz(int row, int colB) { return row * (DQK == 192 ? 512 : 256) + (colB ^ ((row & 15) << 4)); }
template <int DQK> __device__ __forceinline__ void qkt(f32x16& p0, f32x16& p1, const char* Ks, const bf16x8* qr, int r32, int hi) {
  p0 = f32x16{}; p1 = f32x16{};
#pragma unroll
  for (int d0 = 0; d0 < DQK / 16; ++d0) { const int cb = (d0 * 16 + hi * 8) * 2;
    const bf16x8 b0 = *reinterpret_cast<const bf16x8*>(Ks + kswz<DQK>(r32, cb));
    const bf16x8 b1 = *reinterpret_cast<const bf16x8*>(Ks + kswz<DQK>(32 + r32, cb));
    p0 = __builtin_amdgcn_mfma_f32_32x32x16_bf16(b0, qr[d0], p0, 0, 0, 0);
    p1 = __builtin_amdgcn_mfma_f32_32x32x16_bf16(b1, qr[d0], p1, 0, 0, 0);
    if ((d0 & 3) == 3) ATT_SBAR(); }
}
__device__ __forceinline__ int v_st(int k, int c) { const int kk = (k & ~0xC) | ((k & 4) << 1) | ((k & 8) >> 1); return ((kk >> 3) * 4 + (c >> 5)) * 512 + ((kk & 7) * 32 + (c & 31)) * 2; }
__device__ __forceinline__ int v_rd_base(int lane) { return ((lane & 3) << 3) | (((lane >> 2) & 3) << 6) | (((lane >> 4) & 1) << 5) | (((lane >> 5) & 1) << 8); }
constexpr int v_rd_off(int d0, int ks, int half) { return d0 * 512 + ks * 4096 + half * 2048; }
template <int OFF> __device__ __forceinline__ s16x4 tr_read(int vb) {
  s16x4 r; asm volatile("ds_read_b64_tr_b16 %0, %1 offset:%2" : "=&v"(r) : "v"(vb), "i"(OFF) : "memory"); return r;
}
template <int D0> __device__ __forceinline__ void pv_one(f32x16& od, int vb, bf16x8 pa0, bf16x8 pa1, bf16x8 pa2, bf16x8 pa3) {
  const s16x4 l0 = tr_read<v_rd_off(D0, 0, 0)>(vb), h0 = tr_read<v_rd_off(D0, 0, 1)>(vb), l1 = tr_read<v_rd_off(D0, 1, 0)>(vb), h1 = tr_read<v_rd_off(D0, 1, 1)>(vb);
  const s16x4 l2 = tr_read<v_rd_off(D0, 2, 0)>(vb), h2 = tr_read<v_rd_off(D0, 2, 1)>(vb), l3 = tr_read<v_rd_off(D0, 3, 0)>(vb), h3 = tr_read<v_rd_off(D0, 3, 1)>(vb);
  asm volatile("s_waitcnt lgkmcnt(0)" ::: "memory"); ATT_SBAR();
#define ATT_PK(L, H) (bf16x8){L[0], L[1], L[2], L[3], H[0], H[1], H[2], H[3]}
  od = __builtin_amdgcn_mfma_f32_32x32x16_bf16(pa0, ATT_PK(l0, h0), od, 0, 0, 0);
  od = __builtin_amdgcn_mfma_f32_32x32x16_bf16(pa1, ATT_PK(l1, h1), od, 0, 0, 0);
  od = __builtin_amdgcn_mfma_f32_32x32x16_bf16(pa2, ATT_PK(l2, h2), od, 0, 0, 0);
  od = __builtin_amdgcn_mfma_f32_32x32x16_bf16(pa3, ATT_PK(l3, h3), od, 0, 0, 0);
#undef ATT_PK
}
__device__ __forceinline__ void pv_d0(f32x16* o, int vb, bf16x8 pa0, bf16x8 pa1, bf16x8 pa2, bf16x8 pa3) {
  pv_one<0>(o[0], vb, pa0, pa1, pa2, pa3); pv_one<1>(o[1], vb, pa0, pa1, pa2, pa3); pv_one<2>(o[2], vb, pa0, pa1, pa2, pa3); pv_one<3>(o[3], vb, pa0, pa1, pa2, pa3);
}
template <int HALF> __device__ __forceinline__ void na_adjust(f32x16& p, const float* bq, int tcs, float inv_scale) {
#pragma unroll
  for (int r = 0; r < 16; ++r) { constexpr int dummy = 0; (void)dummy; const int kr_ = HALF * 32 + (r & 3) + 8 * (r >> 2);
    const bool valid = (unsigned)(kr_ + tcs) < 16u; const float bv = bq[kr_]; p[r] = valid ? fmaf(bv, inv_scale, p[r]) : -1e30f; }
}
template <int DQK, bool NA>
__device__ __forceinline__ void attn_unit(const bf16_t* __restrict__ Qb, const bf16_t* __restrict__ Kc, const bf16_t* __restrict__ Kl, const bf16_t* __restrict__ Vc, const bf16_t* __restrict__ Vl,
                                          bf16_t* __restrict__ Ob, const int nct, const int NT, const int kr0, const int g0, const float* biasT, const float C, const float thr_raw, const float inv_scale,
                                          char* lds, const int tid) {
  constexpr int LDQ = DQK == 192 ? 1536 : 1024, LDK = LDQ, LDV = 1024, LDO = 2048, SHM_K = 64 * (DQK == 192 ? 512 : 256), NQ = DQK / 16, NCH = DQK / 8, KPT = DQK / 64;
  const int wid = tid >> 6, lane = tid & 63, r32 = lane & 31, hi = lane >> 5;
  char* V_lds = lds; char* K_lds = lds + 2 * SHM_V;
  float* wsw = (float*)(lds + 2 * SHM_V + 2 * SHM_K) + wid * 64; float* li_l = wsw; float* al_l = wsw + 32;
  float m_reg = -1e30f, l_reg = 0.f; f32x16 o[4] = {}; bf16x8 qr[NQ];
  const bf16_t* Qw = Qb + (size_t)(wid * 32 + r32) * LDQ + hi * 8;
#pragma unroll
  for (int d0 = 0; d0 < NQ; ++d0) qr[d0] = *reinterpret_cast<const bf16x8*>(Qw + d0 * 16);
  const int sr = tid >> 4, sc = (tid & 15) * 8, vst0 = v_st(sr, sc), vst1 = v_st(32 + sr, sc);
  const int vb0 = (int)(uintptr_t)V_lds + v_rd_base(lane);
  bf16x8 vs0, vs1, ks[KPT];
#define ATT_SLOAD(t) do { const int _t = (t); const bool _c = _t < nct; const size_t _r0 = _c ? (size_t)_t * 64 : (size_t)(NA ? (kr0 + _t - nct) : (_t - nct)) * 64; \
    const bf16_t* _K = (_c ? Kc : Kl) + _r0 * LDK; const bf16_t* _V = (_c ? Vc : Vl) + _r0 * LDV; \
    vs0 = *reinterpret_cast<const bf16x8*>(_V + (size_t)sr * LDV + sc); vs1 = *reinterpret_cast<const bf16x8*>(_V + (size_t)(32 + sr) * LDV + sc); \
    _Pragma("unroll") for (int _i = 0; _i < KPT; ++_i) { const int _id = tid + _i * NTHR, _row = _id / NCH, _c8 = _id % NCH; ks[_i] = *reinterpret_cast<const bf16x8*>(_K + (size_t)_row * LDK + _c8 * 8); } } while (0)
#define ATT_SWRITE(b) do { *(bf16x8*)(V_lds + (b) * SHM_V + vst0) = vs0; *(bf16x8*)(V_lds + (b) * SHM_V + vst1) = vs1; \
    _Pragma("unroll") for (int _i = 0; _i < KPT; ++_i) { const int _id = tid + _i * NTHR, _row = _id / NCH, _c8 = _id % NCH; *(bf16x8*)(K_lds + (b) * SHM_K + kswz<DQK>(_row, _c8 * 16)) = ks[_i]; } } while (0)
#define ATT_RESC(a) do { if (__any((a) < 1.f)) { if (hi == 0) al_l[r32] = (a); asm volatile("s_waitcnt lgkmcnt(0)" ::: "memory"); \
    _Pragma("unroll") for (int d = 0; d < 4; ++d) _Pragma("unroll") for (int r = 0; r < 16; ++r) o[d][r] *= al_l[crow(r, hi)]; } } while (0)
  const int g = g0 + (wid >> 1), qc = (wid & 1) * 32 + r32;
  int cs = qc - 8; cs = cs < 0 ? 0 : (cs > 48 ? 48 : cs);
  int rs = g - 4; rs = rs < 0 ? 0 : (rs > 24 ? 24 : rs);
  f32x16 p0, p1; float mn, al; bf16x8 pa0, pa1, pa2, pa3;
  ATT_SLOAD(0); asm volatile("s_waitcnt vmcnt(0)" ::: "memory"); ATT_SWRITE(0); __syncthreads();
#pragma nounroll
  for (int t = 0; t < NT; ++t) {
    const int buf = t & 1;
    bool active = true; int kr = 0;
    if (NA && t >= nct) { kr = kr0 + t - nct; active = (kr >= rs) && (kr < rs + 8); }
    if (active) qkt<DQK>(p0, p1, K_lds + buf * SHM_K, qr, r32, hi);
    ATT_SBAR();
    if (t + 1 < NT) ATT_SLOAD(t + 1);
    ATT_SBAR();
    if (active) {
      if (NA && t >= nct) { const float* bq = biasT + (kr - g + 7) * 128 + 63 - qc + 4 * hi; const int tcs = 4 * hi - cs; na_adjust<0>(p0, bq, tcs, inv_scale); na_adjust<1>(p1, bq, tcs, inv_scale); }
      partialSM(p0, p1, m_reg, mn, al, C, thr_raw);
      ATT_RESC(al);
      finishSM(p0, p1, al, l_reg, pa0, pa1, pa2, pa3); ATT_SBAR();
      pv_d0(o, vb0 + buf * SHM_V, pa0, pa1, pa2, pa3);
    }
    if (t + 1 < NT) { asm volatile("s_waitcnt vmcnt(0)" ::: "memory"); ATT_SWRITE(buf ^ 1); }
    __syncthreads();
  }
  if (hi == 0) li_l[r32] = l_reg; asm volatile("s_waitcnt lgkmcnt(0)" ::: "memory");
  float rli[16];
#pragma unroll
  for (int r = 0; r < 16; ++r) rli[r] = __builtin_amdgcn_rcpf(li_l[crow(r, hi)]);
  bf16_t* Ow = Ob + (size_t)(wid * 32) * LDO;
#pragma unroll
  for (int r = 0; r < 16; ++r) { const int orow = crow(r, hi);
#pragma unroll
    for (int d0 = 0; d0 < 4; ++d0) Ow[(size_t)orow * LDO + d0 * 32 + r32] = f2bf(o[d0][r] * rli[r]); }
  __syncthreads();
#undef ATT_SLOAD
#undef ATT_SWRITE
#undef ATT_RESC
}
}

#ifndef ATT_ONLY
#define ATT_ONLY -1
#endif
__device__ __forceinline__ void phase_attn_mfma(KP P, int e, char* lds) {
    float* biasT = (float*)(lds + 2 * att::SHM_V + 2 * 64 * 512 + 8 * 64 * 4);
    constexpr float L2E = 1.4426950408889634f, SC_M = 0.07216878364870322f, SC_N = 0.08838834764831845f;
    const int G = (int)gridDim.x, xo = (G % 64 == 0) ? 1 : 0;
#define ATT_UNIT(u_) (xo ? (((u_) & 7) * 32 + ((u_) >> 3)) : (u_))
    if (ATT_ONLY < 0 || ATT_ONLY == 0)
    for (int u0 = blockIdx.x; u0 < 256; u0 += gridDim.x) {
        const int tid = tid_opaque(); const int u = ATT_UNIT(u0);
        const int b = u >> 6, hh = (u >> 3) & 7, qb = u & 7;
        const size_t qrow = (size_t)b * SEQ + qb * 256, crow0 = (size_t)MLAT + b * CTXL, lrow0 = (size_t)b * SEQ;
        att::attn_unit<192, false>(P->qm + qrow * 1536 + hh * 192, P->km + crow0 * 1536 + hh * 192, P->km + lrow0 * 1536 + hh * 192,
                                   P->vm + crow0 * 1024 + hh * 128, P->vm + lrow0 * 1024 + hh * 128, P->y + qrow * D + hh * 128,
                                   4, 36, 0, 0, biasT, SC_M * L2E, 8.0f / SC_M, 1.0f / SC_M, lds, tid);
    }
    if (ATT_ONLY < 0 || ATT_ONLY == 1)
    for (int u0 = blockIdx.x; u0 < 256; u0 += gridDim.x) {
        const int tid = tid_opaque(); const int u = ATT_UNIT(u0);
        const int b = u >> 6, hh = (u >> 3) & 7, qb = u & 7;
        const size_t qrow = (size_t)b * SEQ + qb * 256, crow0 = (size_t)MLAT + b * CTXL, lrow0 = (size_t)b * SEQ;
        const int g0 = qb * 4; int rs0 = g0 - 4; rs0 = rs0 < 0 ? 0 : (rs0 > 24 ? 24 : rs0); int rs3 = g0 + 3 - 4; rs3 = rs3 < 0 ? 0 : (rs3 > 24 ? 24 : rs3);
        const int nband = rs3 - rs0 + 8;
        for (int i = tid; i < 15 * 128; i += NTHR) { const int ro = i >> 7, dd = (i & 127) - 63; biasT[i] = (dd >= -15 && dd <= 15) ? P->rel_bias[(size_t)((e * 8 + hh) * 15 + ro) * 31 + dd + 15] : 0.f; }
        __syncthreads();
        att::attn_unit<128, true>(P->qn + qrow * 1024 + hh * 128, P->kn + crow0 * 1024 + hh * 128, P->kn + lrow0 * 1024 + hh * 128,
                                  P->vn + crow0 * 1024 + hh * 128, P->vn + lrow0 * 1024 + hh * 128, P->y + qrow * D + 1024 + hh * 128,
                                  4, 4 + nband, rs0, g0, biasT, SC_N * L2E, 8.0f / SC_N, 1.0f / SC_N, lds, tid);
    }
    if (ATT_ONLY < 0 || ATT_ONLY == 2)
    for (int u = blockIdx.x; u < 32; u += gridDim.x) {
        const int tid = tid_opaque();
        const int b = u >> 3, hh = u & 7; const size_t crow0 = (size_t)MLAT + b * CTXL;
        att::attn_unit<192, false>(P->qm + crow0 * 1536 + hh * 192, P->km + crow0 * 1536 + hh * 192, P->km + crow0 * 1536 + hh * 192,
                                   P->vm + crow0 * 1024 + hh * 128, P->vm + crow0 * 1024 + hh * 128, P->y + crow0 * D + hh * 128,
                                   4, 4, 0, 0, biasT, SC_M * L2E, 8.0f / SC_M, 1.0f / SC_M, lds, tid);
    }
    if (ATT_ONLY < 0 || ATT_ONLY == 3)
    for (int u = (G >= 64 ? (int)blockIdx.x - 32 : (int)blockIdx.x); u < 32; u += gridDim.x) { if (u < 0) continue;
        const int tid = tid_opaque();
        const int b = u >> 3, hh = u & 7; const size_t crow0 = (size_t)MLAT + b * CTXL;
        att::attn_unit<128, false>(P->qn + crow0 * 1024 + hh * 128, P->kn + crow0 * 1024 + hh * 128, P->kn + crow0 * 1024 + hh * 128,
                                   P->vn + crow0 * 1024 + hh * 128, P->vn + crow0 * 1024 + hh * 128, P->y + crow0 * D + 1024 + hh * 128,
                                   4, 4, 0, 0, biasT, SC_N * L2E, 8.0f / SC_N, 1.0f / SC_N, lds, tid);
    }
}

__device__ __forceinline__ int hg_seqrow(int b, int dir, int s) {
    if (dir == 0) return s < CTXL ? MLAT + b * CTXL + s : b * SEQ + (s - CTXL);
    return s < CTXL ? MLAT + b * CTXL + (CTXL - 1 - s) : b * SEQ + (SEQ - 1 - (s - CTXL));
}
namespace hg {
typedef short bf16x8 __attribute__((ext_vector_type(8)));
typedef float f32x4 __attribute__((ext_vector_type(4)));
constexpr int QS = 272, KTS = 144, VS = 144, PS = 144, SES = 272;
constexpr int OFF_Q = 0, OFF_K = OFF_Q + 64 * QS, OFF_KT = OFF_K + 64 * QS, OFF_V = OFF_KT + 128 * KTS, OFF_P = OFF_V + 32 * VS, OFF_SE = OFF_P + 64 * PS,
              OFF_SEG = OFF_SE + 32 * SES, OFF_E = OFF_SEG + 4 * 128 * 4, OFF_END = OFF_E + 3 * 128 * 4;
__device__ __forceinline__ bf16x8 frag(const char* base, int stride, int row, int kbyte) { return *reinterpret_cast<const bf16x8*>(base + row * stride + kbyte); }
}
__device__ __forceinline__ void phase_hgrn_pre(KP P, int o, char* lds) {
    using namespace hg;
    constexpr int VS2 = 144, OFF_V2 = OFF_KT + 128 * KTS, OFF_P2 = OFF_V2 + 128 * VS2, OFF_SEG2 = OFF_P2 + 64 * PS;
    const int tid = tid_opaque(), lane = tid & 63, w = tid >> 6, l15 = lane & 15, lq = lane >> 4;
    const int d2 = (tid & 63) * 2, tq = tid >> 6;
    char* Qt = lds + OFF_Q; char* Kt = lds + OFF_K; char* Ktt = lds + OFF_KT; char* Vt = lds + OFF_V2; char* Pm = lds + OFF_P2;
    float* seg = (float*)(lds + OFF_SEG2);
    const bf16_t* pb = P->p;
    for (int unit = blockIdx.x; unit < 64 * 36; unit += gridDim.x) {
        const int ud = unit / 36, c = unit % 36; const int dir = ud & 1, hd = (ud >> 1) & 7, b = ud >> 4;
        const float2 lbv = *(const float2*)(P->lb + (dir * 2 + o) * 1024 + hd * 128 + d2);
        const int zoff = dir ? 3072 : 2048;
        float qv[2][8], kk[2][8], cum[2][8];
        {
            unsigned qw[8], zw[8];
#pragma unroll
            for (int i = 0; i < 8; ++i) { const size_t row = hg_seqrow(b, dir, c * 64 + tq * 8 + i); qw[i] = *(const unsigned*)(pb + row * ODW + hd * 128 + d2); zw[i] = *(const unsigned*)(pb + row * ODW + zoff + hd * 128 + d2); }
            float run0 = 0.f, run1 = 0.f;
#pragma unroll
            for (int i = 0; i < 8; ++i) {
                float f0 = lbv.x + (1.0f - lbv.x) * sigmoid_f(bflo(zw[i])), f1 = lbv.y + (1.0f - lbv.y) * sigmoid_f(bfhi(zw[i]));
                f0 = fmaxf(f0, 1e-30f); f1 = fmaxf(f1, 1e-30f);
                run0 += __logf(f0); run1 += __logf(f1); cum[0][i] = run0; cum[1][i] = run1; kk[0][i] = 1.0f - f0; kk[1][i] = 1.0f - f1;
                qv[0][i] = silu_f(bflo(qw[i])); qv[1][i] = silu_f(bfhi(qw[i]));
            }
        }
        const int vs_ = tid >> 3, ve16 = (tid & 7) * 16;
        const uint4 vr0 = *(const uint4*)(pb + (size_t)hg_seqrow(b, dir, c * 64 + vs_) * ODW + 1024 + hd * 128 + ve16), vr1 = *(const uint4*)(pb + (size_t)hg_seqrow(b, dir, c * 64 + vs_) * ODW + 1024 + hd * 128 + ve16 + 8);
        __syncthreads();
        *(float2*)(seg + tq * 128 + d2) = make_float2(cum[0][7], cum[1][7]);
        __syncthreads();
        {
            float off0 = 0.f, off1 = 0.f, cr0 = 0.f, cr1 = 0.f, last0 = 0.f, last1 = 0.f;
#pragma unroll
            for (int g = 0; g < 8; ++g) { const float2 sg = *(const float2*)(seg + g * 128 + d2);
                if (g < tq) { off0 += sg.x; off1 += sg.y; } if (g < 4) { cr0 += sg.x; cr1 += sg.y; } last0 += sg.x; last1 += sg.y; }
            unsigned kt_pk[8];
#pragma unroll
            for (int i = 0; i < 8; ++i) {
                const float a0 = off0 + cum[0][i] - cr0, a1 = off1 + cum[1][i] - cr1; const int t = tq * 8 + i;
                const float q0 = qv[0][i] * __expf(fminf(a0, 80.f)), q1 = qv[1][i] * __expf(fminf(a1, 80.f));
                const float k0 = kk[0][i] * __expf(fminf(-a0, 80.f)), k1 = kk[1][i] * __expf(fminf(-a1, 80.f));
                const unsigned kp = cvt_pk_bf16(k0, k1); kt_pk[i] = kp;
                *(unsigned*)(Qt + t * QS + d2 * 2) = cvt_pk_bf16(q0, q1); *(unsigned*)(Kt + t * QS + d2 * 2) = kp;
            }
            uint4 r0, r1;
            r0.x = (kt_pk[0] & 0xffffu) | (kt_pk[1] << 16); r0.y = (kt_pk[2] & 0xffffu) | (kt_pk[3] << 16); r0.z = (kt_pk[4] & 0xffffu) | (kt_pk[5] << 16); r0.w = (kt_pk[6] & 0xffffu) | (kt_pk[7] << 16);
            r1.x = (kt_pk[0] >> 16) | (kt_pk[1] & 0xffff0000u); r1.y = (kt_pk[2] >> 16) | (kt_pk[3] & 0xffff0000u); r1.z = (kt_pk[4] >> 16) | (kt_pk[5] & 0xffff0000u); r1.w = (kt_pk[6] >> 16) | (kt_pk[7] & 0xffff0000u);
            *(uint4*)(Ktt + d2 * KTS + tq * 16) = r0; *(uint4*)(Ktt + (d2 + 1) * KTS + tq * 16) = r1;
            if (tq == 0) { float* g = P->he + (size_t)unit * 384;
                *(float2*)(g + d2) = make_float2(__expf(cr0), __expf(cr1)); *(float2*)(g + 128 + d2) = make_float2(__expf(last0), __expf(last1)); *(float2*)(g + 256 + d2) = make_float2(__expf(last0 - cr0), __expf(last1 - cr1)); }
            const unsigned vw[8] = {vr0.x, vr0.y, vr0.z, vr0.w, vr1.x, vr1.y, vr1.z, vr1.w};
#pragma unroll
            for (int j = 0; j < 8; ++j) { *(bf16_t*)(Vt + (ve16 + 2 * j) * VS2 + vs_ * 2) = (bf16_t)(vw[j] & 0xffffu); *(bf16_t*)(Vt + (ve16 + 2 * j + 1) * VS2 + vs_ * 2) = (bf16_t)(vw[j] >> 16); }
        }
        __syncthreads();
        {
            const int t = tid >> 3, c16 = (tid & 7) * 16;
            const uint4 x0 = *(const uint4*)(Qt + t * QS + c16 * 2), x1 = *(const uint4*)(Qt + t * QS + c16 * 2 + 16);
            bf16_t* g = P->hq + ((size_t)unit * 64 + t) * 128 + c16; *(uint4*)g = x0; *(uint4*)(g + 8) = x1;
        }
        {
            const int st = w & 3;
#pragma unroll
            for (int j = 0; j < 2; ++j) {
                const int tt = (w >> 2) * 2 + j;
                f32x4 acc = (f32x4){0.f, 0.f, 0.f, 0.f};
                if (st <= tt) {
#pragma unroll
                    for (int ks = 0; ks < 4; ++ks) { const int kb2 = (ks * 32 + 8 * lq) * 2;
                        acc = __builtin_amdgcn_mfma_f32_16x16x32_bf16(frag(Kt, QS, st * 16 + l15, kb2), frag(Qt, QS, tt * 16 + l15, kb2), acc, 0, 0, 0); }
                }
                const int s_i = st * 16 + 4 * lq, t_i = tt * 16 + l15;
                const float m0 = (st <= tt && s_i + 0 <= t_i) ? acc[0] : 0.f, m1 = (st <= tt && s_i + 1 <= t_i) ? acc[1] : 0.f;
                const float m2 = (st <= tt && s_i + 2 <= t_i) ? acc[2] : 0.f, m3 = (st <= tt && s_i + 3 <= t_i) ? acc[3] : 0.f;
                uint2 pk; pk.x = cvt_pk_bf16(m0, m1); pk.y = cvt_pk_bf16(m2, m3);
                *(uint2*)(Pm + t_i * PS + s_i * 2) = pk;
            }
        }
        {
            bf16_t* g = P->hu + (size_t)unit * 16384;
#pragma unroll
            for (int et = 0; et < 8; ++et) {
                f32x4 u = (f32x4){0.f, 0.f, 0.f, 0.f};
#pragma unroll
                for (int ks = 0; ks < 2; ++ks) { const int kb2 = (ks * 32 + 8 * lq) * 2;
                    u = __builtin_amdgcn_mfma_f32_16x16x32_bf16(frag(Ktt, KTS, w * 16 + l15, kb2), frag(Vt, VS2, et * 16 + l15, kb2), u, 0, 0, 0); }
                uint2 pk; pk.x = cvt_pk_bf16(u[0], u[1]); pk.y = cvt_pk_bf16(u[2], u[3]);
                *(uint2*)(g + ((size_t)(et * 8 + w) * 64 + lane) * 4) = pk;
            }
        }
        __syncthreads();
        {
            float* obuf = dir ? P->ob : P->of;
#pragma unroll
            for (int tt = 0; tt < 4; ++tt) {
                f32x4 acc = (f32x4){0.f, 0.f, 0.f, 0.f};
#pragma unroll
                for (int ks = 0; ks < 2; ++ks) { const int kb2 = (ks * 32 + 8 * lq) * 2;
                    acc = __builtin_amdgcn_mfma_f32_16x16x32_bf16(frag(Vt, VS2, w * 16 + l15, kb2), frag(Pm, PS, tt * 16 + l15, kb2), acc, 0, 0, 0); }
                const size_t row = hg_seqrow(b, dir, c * 64 + tt * 16 + l15);
                *(f32x4*)(obuf + row * 1024 + hd * 128 + w * 16 + 4 * lq) = acc;
            }
        }
    }
    __syncthreads();
}
__device__ __forceinline__ void phase_hgrn_seq(KP P, char* lds) {
    using namespace hg;
    const int tid = tid_opaque(), lane = tid & 63, w = tid >> 6, l15 = lane & 15, lq = lane >> 4;
    char* SEt0 = lds;
    for (int unit = blockIdx.x; unit < 256; unit += gridDim.x) {
        const int eb = unit & 3, ud = unit >> 2; const int dir = ud & 1, hd = (ud >> 1) & 7, b = ud >> 4;
        float* obuf = dir ? P->ob : P->of;
        const int et_o = w & 1, tt_o = w >> 1, dd = w * 16 + 4 * lq;
        f32x4 S[2]; S[0] = (f32x4){0.f, 0.f, 0.f, 0.f}; S[1] = S[0];
        bf16x8 qf[4]; uint2 uu[2]; f32x4 er4, el4, elr4, ov4;
#define HG_LOAD(c_) do { const size_t cu_ = (size_t)ud * 36 + (c_); const bf16_t* hq_ = P->hq + (cu_ * 64 + tt_o * 16 + l15) * 128 + 8 * lq; \
        _Pragma("unroll") for (int ks = 0; ks < 4; ++ks) qf[ks] = *reinterpret_cast<const bf16x8*>(hq_ + ks * 32); \
        const bf16_t* hu_ = P->hu + cu_ * 16384; \
        _Pragma("unroll") for (int et = 0; et < 2; ++et) uu[et] = *(const uint2*)(hu_ + ((size_t)((eb * 2 + et) * 8 + w) * 64 + lane) * 4); \
        const float* he_ = P->he + cu_ * 384 + dd; er4 = *(const f32x4*)he_; el4 = *(const f32x4*)(he_ + 128); elr4 = *(const f32x4*)(he_ + 256); \
        ov4 = *(const f32x4*)(obuf + (size_t)hg_seqrow(b, dir, (c_) * 64 + tt_o * 16 + l15) * 1024 + hd * 128 + eb * 32 + et_o * 16 + 4 * lq); } while (0)
        HG_LOAD(0);
        __syncthreads();
#pragma nounroll
        for (int c = 0; c < 36; ++c) {
            char* SEt = SEt0 + (c & 1) * (32 * SES);
#pragma unroll
            for (int et = 0; et < 2; ++et) { const f32x4 v4 = S[et] * er4; uint2 pk; pk.x = cvt_pk_bf16(v4[0], v4[1]); pk.y = cvt_pk_bf16(v4[2], v4[3]);
                *(uint2*)(SEt + (et * 16 + l15) * SES + dd * 2) = pk; }
            const bf16x8 q0 = qf[0], q1 = qf[1], q2 = qf[2], q3 = qf[3]; const uint2 u0 = uu[0], u1 = uu[1]; const f32x4 el = el4, elr = elr4, ov = ov4;
            __syncthreads();
            if (c + 1 < 36) HG_LOAD(c + 1);
            f32x4 acc = (f32x4){0.f, 0.f, 0.f, 0.f};
            acc = __builtin_amdgcn_mfma_f32_16x16x32_bf16(frag(SEt, SES, et_o * 16 + l15, (0 * 32 + 8 * lq) * 2), q0, acc, 0, 0, 0);
            acc = __builtin_amdgcn_mfma_f32_16x16x32_bf16(frag(SEt, SES, et_o * 16 + l15, (1 * 32 + 8 * lq) * 2), q1, acc, 0, 0, 0);
            acc = __builtin_amdgcn_mfma_f32_16x16x32_bf16(frag(SEt, SES, et_o * 16 + l15, (2 * 32 + 8 * lq) * 2), q2, acc, 0, 0, 0);
            acc = __builtin_amdgcn_mfma_f32_16x16x32_bf16(frag(SEt, SES, et_o * 16 + l15, (3 * 32 + 8 * lq) * 2), q3, acc, 0, 0, 0);
            float* op = obuf + (size_t)hg_seqrow(b, dir, c * 64 + tt_o * 16 + l15) * 1024 + hd * 128 + eb * 32 + et_o * 16 + 4 * lq;
            *(f32x4*)op = ov + acc;
            const f32x4 U0 = (f32x4){bflo(u0.x), bfhi(u0.x), bflo(u0.y), bfhi(u0.y)}, U1 = (f32x4){bflo(u1.x), bfhi(u1.x), bflo(u1.y), bfhi(u1.y)};
            S[0] = el * S[0] + elr * U0; S[1] = el * S[1] + elr * U1;
        }
        __syncthreads();
#undef HG_LOAD
    }
}

__device__ __forceinline__ void phase_hgrn_readout(KP P, int o, int M) {
    const int tid = tid_opaque(), lane = tid & 63, w = tid >> 6;
    for (int u = blockIdx.x * 8 + w; u < M * 8; u += gridDim.x * 8) {
        const int row = u >> 3, hd = u & 7;
        const size_t off = (size_t)row * 1024 + hd * 128 + lane * 2;
        const float2 a = *(const float2*)(P->of + off), bq = *(const float2*)(P->ob + off);
        const float v0 = a.x + bq.x, v1 = a.y + bq.y;
        float ss = wave_sum(v0 * v0 + v1 * v1);
        const float rstd = rsqrtf(ss * (1.0f / 128.0f) + NORM_EPS);
        const float2 g = *(const float2*)(P->hgrn_norm_g + o * 1024 + hd * 128 + lane * 2);
        const unsigned gtw = *(const unsigned*)(P->p + (size_t)row * ODW + 4096 + hd * 128 + lane * 2); const float2 gt = make_float2(bflo(gtw), bfhi(gtw));
        *(unsigned*)(P->y + (size_t)row * D + hd * 128 + lane * 2) = cvt_pk_bf16(v0 * rstd * g.x * silu_f(gt.x), v1 * rstd * g.y * silu_f(gt.y));
    }
}

__device__ __forceinline__ void phase_hyena_prep(KP P, int o, int M) {
    const float* cw = P->conv_w + (size_t)o * 3 * 3072; const float* cb = P->conv_b + o * 3072;
    const size_t total = (size_t)M * 128;
    for (size_t i = (size_t)blockIdx.x * NTHR + tid_opaque(); i < total; i += (size_t)gridDim.x * NTHR) {
        const int row = (int)(i >> 7), c8 = (int)(i & 127) * 8;
        int t, n;
        if (row < MLAT) { t = row & (SEQ - 1); n = SEQ; } else { t = (row - MLAT) & (CTXL - 1); n = CTXL; }
        const bf16_t* u = P->p + (size_t)row * ODW + 5120;
        float r3[3][8];
#pragma unroll
        for (int part = 0; part < 3; ++part) {
            const int j = part * 1024 + c8;
            const uint4 x1 = *(const uint4*)(u + j);
            uint4 x0 = make_uint4(0u, 0u, 0u, 0u), x2 = x0;
            if (t > 0) x0 = *(const uint4*)(u + j - ODW);
            if (t < n - 1) x2 = *(const uint4*)(u + j + ODW);
            const float4 b0 = *(const float4*)(cb + j), b1 = *(const float4*)(cb + j + 4);
            const float4 w00 = *(const float4*)(cw + j), w01 = *(const float4*)(cw + j + 4), w10 = *(const float4*)(cw + 3072 + j), w11 = *(const float4*)(cw + 3072 + j + 4),
                         w20 = *(const float4*)(cw + 6144 + j), w21 = *(const float4*)(cw + 6144 + j + 4);
            const float bb[8] = {b0.x, b0.y, b0.z, b0.w, b1.x, b1.y, b1.z, b1.w};
            const float wa[8] = {w00.x, w00.y, w00.z, w00.w, w01.x, w01.y, w01.z, w01.w}, wb[8] = {w10.x, w10.y, w10.z, w10.w, w11.x, w11.y, w11.z, w11.w},
                        wc[8] = {w20.x, w20.y, w20.z, w20.w, w21.x, w21.y, w21.z, w21.w};
            const unsigned xa[4] = {x0.x, x0.y, x0.z, x0.w}, xb[4] = {x1.x, x1.y, x1.z, x1.w}, xc[4] = {x2.x, x2.y, x2.z, x2.w};
#pragma unroll
            for (int q = 0; q < 4; ++q) {
                r3[part][2 * q]     = bb[2 * q]     + wa[2 * q]     * bflo(xa[q]) + wb[2 * q]     * bflo(xb[q]) + wc[2 * q]     * bflo(xc[q]);
                r3[part][2 * q + 1] = bb[2 * q + 1] + wa[2 * q + 1] * bfhi(xa[q]) + wb[2 * q + 1] * bfhi(xb[q]) + wc[2 * q + 1] * bfhi(xc[q]);
            }
        }
        float* zx = P->x0b + (size_t)row * 1024 + c8; float* zz = P->zb + (size_t)row * 1024 + c8;
        *(float4*)zx = make_float4(r3[0][0], r3[0][1], r3[0][2], r3[0][3]); *(float4*)(zx + 4) = make_float4(r3[0][4], r3[0][5], r3[0][6], r3[0][7]);
        *(float4*)zz = make_float4(r3[2][0] * r3[1][0], r3[2][1] * r3[1][1], r3[2][2] * r3[1][2], r3[2][3] * r3[1][3]);
        *(float4*)(zz + 4) = make_float4(r3[2][4] * r3[1][4], r3[2][5] * r3[1][5], r3[2][6] * r3[1][6], r3[2][7] * r3[1][7]);
    }
}
__device__ __forceinline__ void phase_hyena_conv(KP P, int o, bool do_lat, bool do_ctx, float* lds) {
    (void)do_lat;
    if (!do_ctx) return;
    float* hb = lds;
    float* zs = lds + 511 * 32;
    const int tid = tid_opaque(), c = tid & 31, tg = tid >> 5;
    const float* hf = P->filt_ctx + ((size_t)o * 2 + 0) * CTXL * 1024; const float* hbw = P->filt_ctx + ((size_t)o * 2 + 1) * CTXL * 1024;
    for (int unit = blockIdx.x; unit < 4 * 32; unit += gridDim.x) {
        const int b = unit >> 5, c0 = (unit & 31) * 32; const size_t seqbase = (size_t)MLAT + b * CTXL;
        __syncthreads();
        for (int idx = tid; idx < 511 * 32; idx += NTHR) { const int jj = idx >> 5, cc = idx & 31; const int j = jj - 255;
            hb[idx] = j >= 0 ? hf[(size_t)j * 1024 + c0 + cc] : hbw[(size_t)(-j) * 1024 + c0 + cc]; }
        for (int idx = tid; idx < 256 * 32; idx += NTHR) { const int s2 = idx >> 5, cc = idx & 31; zs[idx] = P->zb[(seqbase + s2) * 1024 + c0 + cc]; }
        __syncthreads();
        float acc[16];
#pragma unroll
        for (int i = 0; i < 16; ++i) acc[i] = 0.f;
#pragma unroll 4
        for (int s2 = 0; s2 < 256; ++s2) {
            const float zv = zs[s2 * 32 + c];
            const float* hp = hb + (tg * 16 - s2 + 255) * 32 + c;
#pragma unroll
            for (int i = 0; i < 16; ++i) acc[i] += hp[i * 32] * zv;
        }
        const float sk = P->skip[o * 1024 + c0 + c];
#pragma unroll
        for (int i = 0; i < 16; ++i) {
            const size_t row = seqbase + tg * 16 + i;
            const float zt = zs[(tg * 16 + i) * 32 + c], x0 = P->x0b[row * 1024 + c0 + c];
            P->y[row * D + 1024 + c0 + c] = f2bf(x0 * (acc[i] + zt * sk));
        }
    }
}

namespace fftc {
constexpr int SEQP = 4096 + 512;
__device__ __forceinline__ int fphys(int i) { return i + (i >> 3); }
__device__ __forceinline__ float2 cmul(float2 a, float2 b) { return make_float2(a.x * b.x - a.y * b.y, a.x * b.y + a.y * b.x); }
__device__ __forceinline__ float2 cmulc(float2 a, float2 b) { return make_float2(a.x * b.x + a.y * b.y, a.y * b.x - a.x * b.y); }
__device__ __forceinline__ float2 cadd(float2 a, float2 b) { return make_float2(a.x + b.x, a.y + b.y); }
__device__ __forceinline__ float2 csub(float2 a, float2 b) { return make_float2(a.x - b.x, a.y - b.y); }
template <int S, bool INV> __device__ __forceinline__ void pass(float2* X, const float2* tw, int tid) {
    const int blk = tid / S, j0 = tid % S, e0 = blk * 8 * S + j0;
    float2 v[8];
#pragma unroll
    for (int k = 0; k < 8; ++k) v[k] = X[fphys(e0 + k * S)];
    const float2 wA0 = tw[j0 * (512 / S)], wB0 = cmul(wA0, wA0), wC = cmul(wB0, wB0);
    constexpr float R = 0.70710678118654752f;
    const float2 w8[4] = {make_float2(1.f, 0.f), make_float2(R, -R), make_float2(0.f, -1.f), make_float2(-R, -R)};
    const float2 wBk[2] = {wB0, make_float2(wB0.y, -wB0.x)};
    if (!INV) {
#pragma unroll
        for (int k = 0; k < 4; ++k) { const float2 a = v[k], b = v[k + 4]; v[k] = cadd(a, b); v[k + 4] = cmul(csub(a, b), cmul(wA0, w8[k])); }
#pragma unroll
        for (int base = 0; base < 8; base += 4)
#pragma unroll
            for (int k = 0; k < 2; ++k) { const float2 a = v[base + k], b = v[base + k + 2]; v[base + k] = cadd(a, b); v[base + k + 2] = cmul(csub(a, b), wBk[k]); }
#pragma unroll
        for (int k = 0; k < 8; k += 2) { const float2 a = v[k], b = v[k + 1]; v[k] = cadd(a, b); v[k + 1] = cmul(csub(a, b), wC); }
    } else {
#pragma unroll
        for (int k = 0; k < 8; k += 2) { const float2 a = v[k], b = cmulc(v[k + 1], wC); v[k] = cadd(a, b); v[k + 1] = csub(a, b); }
#pragma unroll
        for (int base = 0; base < 8; base += 4)
#pragma unroll
            for (int k = 0; k < 2; ++k) { const float2 a = v[base + k], b = cmulc(v[base + k + 2], wBk[k]); v[base + k] = cadd(a, b); v[base + k + 2] = csub(a, b); }
#pragma unroll
        for (int k = 0; k < 4; ++k) { const float2 a = v[k], b = cmulc(v[k + 4], cmul(wA0, w8[k])); v[k] = cadd(a, b); v[k + 4] = csub(a, b); }
    }
#pragma unroll
    for (int k = 0; k < 8; ++k) X[fphys(e0 + k * S)] = v[k];
}
template <int S, bool INV> __device__ __forceinline__ void pass4(float2* X, const float2* tw, int tid) {
#pragma nounroll
    for (int q = 0; q < 4; ++q) pass<S, INV>(X + q * SEQP, tw, tid);
    __syncthreads();
}
__device__ __forceinline__ void fwd4(float2* X, const float2* tw, int tid) { pass4<512, false>(X, tw, tid); pass4<64, false>(X, tw, tid); pass4<8, false>(X, tw, tid); pass4<1, false>(X, tw, tid); }
__device__ __forceinline__ void inv4(float2* X, const float2* tw, int tid) { pass4<1, true>(X, tw, tid); pass4<8, true>(X, tw, tid); pass4<64, true>(X, tw, tid); pass4<512, true>(X, tw, tid); }
__device__ __forceinline__ void init_tw(float2* tw, int tid) { if (tid < 512) { float sn, cs; sincospif((float)tid * (1.0f / 2048.0f), &sn, &cs); tw[tid] = make_float2(cs, -sn); } }
}

__device__ __forceinline__ void phase_filter_fft(KP P, char* lds) {
    const int tid = tid_opaque();
    float2* X = (float2*)lds; float2* tw = X + 4 * fftc::SEQP;
    fftc::init_tw(tw, tid);
    for (int unit = blockIdx.x; unit < 512; unit += gridDim.x) {
        const int o = unit >> 8, c0 = (unit & 255) * 4;
        const float* hf = P->filt_lat + ((size_t)o * 2 + 0) * SEQ * 1024 + c0; const float* hb = P->filt_lat + ((size_t)o * 2 + 1) * SEQ * 1024 + c0;
        __syncthreads();
        for (int i = tid; i < 4096; i += NTHR) {
            float4 val = make_float4(0.f, 0.f, 0.f, 0.f);
            if (i < 2048) val = *(const float4*)(hf + (size_t)i * 1024); else if (i > 2048) val = *(const float4*)(hb + (size_t)(4096 - i) * 1024);
            if (i == 0) { const float4 sk = *(const float4*)(P->skip + o * 1024 + c0); val.x += sk.x; val.y += sk.y; val.z += sk.z; val.w += sk.w; }
            const int p = fftc::fphys(i);
            X[p] = make_float2(val.x, 0.f); X[fftc::SEQP + p] = make_float2(val.y, 0.f); X[2 * fftc::SEQP + p] = make_float2(val.z, 0.f); X[3 * fftc::SEQP + p] = make_float2(val.w, 0.f);
        }
        __syncthreads();
        fftc::fwd4(X, tw, tid);
        for (int q = 0; q < 4; ++q) { float2* dst = P->kf + ((size_t)o * 1024 + c0 + q) * 4096;
            for (int i = tid; i < 4096; i += NTHR) { const float2 v = X[q * fftc::SEQP + fftc::fphys(i)]; dst[i] = make_float2(v.x * (1.0f / 4096.0f), v.y * (1.0f / 4096.0f)); } }
    }
}
__device__ __forceinline__ void phase_hyena_fft(KP P, int o, char* lds) {
    const int tid = tid_opaque();
    float2* X = (float2*)lds; float2* tw = X + 4 * fftc::SEQP; float* Xf = (float*)lds;
    fftc::init_tw(tw, tid);
    for (int unit = blockIdx.x; unit < 512; unit += gridDim.x) {
        const int c0 = (unit >> 1) * 4, b0 = (unit & 1) * 2;
        __syncthreads();
        for (int i = tid; i < 4096; i += NTHR) {
            const int t = i & 2047, bb = i >> 11; const size_t row = (size_t)(b0 + bb) * SEQ + t;
            const float4 val = *(const float4*)(P->zb + row * 1024 + c0);
            const int p = fftc::fphys(t);
            Xf[2 * p + bb] = val.x; Xf[2 * (fftc::SEQP + p) + bb] = val.y; Xf[2 * (2 * fftc::SEQP + p) + bb] = val.z; Xf[2 * (3 * fftc::SEQP + p) + bb] = val.w;
        }
        for (int i = tid; i < 2048; i += NTHR) { const int p = fftc::fphys(2048 + i); const float2 z2 = make_float2(0.f, 0.f);
            X[p] = z2; X[fftc::SEQP + p] = z2; X[2 * fftc::SEQP + p] = z2; X[3 * fftc::SEQP + p] = z2; }
        __syncthreads();
        fftc::fwd4(X, tw, tid);
        for (int q = 0; q < 4; ++q) { const float2* kfp = P->kf + ((size_t)o * 1024 + c0 + q) * 4096;
            for (int i = tid; i < 4096; i += NTHR) { const int p = q * fftc::SEQP + fftc::fphys(i); X[p] = fftc::cmul(X[p], kfp[i]); } }
        __syncthreads();
        fftc::inv4(X, tw, tid);
        for (int i = tid; i < 4096; i += NTHR) {
            const int t = i & 2047, bb = i >> 11; const size_t row = (size_t)(b0 + bb) * SEQ + t;
            const int p = fftc::fphys(t);
            const float4 x0 = *(const float4*)(P->x0b + row * 1024 + c0);
            const float y0 = x0.x * Xf[2 * p + bb], y1 = x0.y * Xf[2 * (fftc::SEQP + p) + bb];
            const float y2 = x0.z * Xf[2 * (2 * fftc::SEQP + p) + bb], y3 = x0.w * Xf[2 * (3 * fftc::SEQP + p) + bb];
            uint2 w; w.x = cvt_pk_bf16(y0, y1); w.y = cvt_pk_bf16(y2, y3);
            *(uint2*)(P->y + row * D + 1024 + c0) = w;
        }
    }
}

__device__ __forceinline__ void phase_final(KP P) {
    const int tid = tid_opaque(), lane = tid & 63, w = tid >> 6;
    for (int row = blockIdx.x * 8 + w; row < MLAT; row += gridDim.x * 8) {
        const float* hr = P->h + (size_t)row * D;
        float4 v[8]; float ss = 0.f;
#pragma unroll
        for (int i = 0; i < 8; ++i) { v[i] = *(const float4*)(hr + i * 256 + lane * 4); ss += v[i].x * v[i].x + v[i].y * v[i].y + v[i].z * v[i].z + v[i].w * v[i].w; }
        ss = wave_sum(ss);
        const float rstd = rsqrtf(ss * (1.0f / D) + NORM_EPS);
        float* orow = P->out + (size_t)row * D;
#pragma unroll
        for (int i = 0; i < 8; ++i) {
            const int col = i * 256 + lane * 4;
            const float4 gg = *(const float4*)(P->final_norm_g + col);
            *(float4*)(orow + col) = make_float4(v[i].x * rstd * gg.x, v[i].y * rstd * gg.y, v[i].z * rstd * gg.z, v[i].w * rstd * gg.w);
        }
    }
}

__global__ void __launch_bounds__(NTHR, 2) mega(Params Pk) {
    extern __shared__ __attribute__((aligned(16))) unsigned char lds_raw[];
    float* lds = (float*)lds_raw;
    volatile LAS unsigned* barw = (volatile LAS unsigned*)((LAS unsigned char*)lds_raw + LDS_BARW_OFF);
    if (threadIdx.x < 4) barw[threadIdx.x] = 0u;
    __syncthreads();
    XcdBarrier bar; bar.bar = Pk.bar; bar.x = 0; bar.st = barw;
    const int lo = Pk.ph_lo, hi = Pk.ph_hi;
    if (hi - lo > 1) bar = xcd_barrier_post(Pk.bar, barw);
    int ph = 0;
#ifndef ONLY_SITE
#define ONLY_SITE -1
#endif
#ifndef DUP_SITE
#define DUP_SITE -1
#endif
#define PHASE(id, body) do { if (ONLY_SITE < 0 || ONLY_SITE == (id)) { if (ph >= lo && ph < hi) { KP P = kargs(); int reps_ = 1; if (DUP_SITE == (id)) { reps_ = 2; asm volatile("" : "+s"(reps_)); } for (int rep_ = 0; rep_ < reps_; ++rep_) { body; if (rep_ + 1 < reps_) __syncthreads(); } if (ph + 1 < hi) xcd_barrier(bar); } } ++ph; } while (0)

    LAS unsigned char* ldsl = (LAS unsigned char*)lds_raw;
    PHASE(0, (phase_prologue(P, lds), phase_convert_weights(P, lds)));
    for (int l = 0; l < DEPTH; ++l) {
        const bool ctx_out = l < DEPTH - 1;
        const int Mo = ctx_out ? MTOT : MLAT;
        PHASE(1, (phase_norm(P, l, 0, MTOT, l > 0, (l & 1) == 0), (l == 0 ? phase_filter_fft(P, (char*)lds_raw) : (void)0)));
        if ((l & 1) == 0) {
            const int e = l >> 1;
            PHASE(2, (run_gemm(ldsl, P->a, P->wt_ev + (size_t)e * EVP * D, MTOT, EVP, D, EpiEvenRoute{P->qm, P->ckv, P->qn, P->kn, P->vn, P->kpe, P->ssq})));
            PHASE(4, (phase_rope_fix(P), run_gemm(ldsl, P->ckv, P->wt_ukv + (size_t)e * D * 512, MTOT, D, 512, EpiKV{P->km, P->vm, P->ssq})));
            PHASE(5, phase_attn_mfma(P, e, (char*)lds_raw));
        } else {
            const int o = l >> 1;
            PHASE(6, (run_gemm(ldsl, P->a, P->wt_od + (size_t)o * ODW * D, MTOT, ODW, D, EpiStoreBf16{P->p, ODW})));
            PHASE(7, (phase_hgrn_pre(P, o, (char*)lds_raw), phase_hyena_prep(P, o, MTOT)));
            PHASE(16, (phase_hgrn_seq(P, (char*)lds_raw), phase_hyena_fft(P, o, (char*)lds_raw), phase_hyena_conv(P, o, false, ctx_out, lds)));
            PHASE(8, phase_hgrn_readout(P, o, Mo));
        }
        PHASE(9, (run_gemm_split(ldsl, P->y, P->wt_out + (size_t)l * D * D, Mo, D, D, EpiResid{P->h, P->mod + (size_t)l * 5 * 6 * D + 2 * D, P->kv, (l == 0 ? P->x : (const float*)P->h)})));
        PHASE(10, phase_norm(P, l, 1, Mo, ctx_out, false));
        PHASE(11, (run_gemm(ldsl, P->a, P->wt_w1 + (size_t)l * HID * D, Mo, HID, D, EpiRelu2Bf16{P->u, HID})));
        PHASE(12, (run_gemm_split(ldsl, P->u, P->wt_w2 + (size_t)l * D * HID, Mo, D, HID, EpiResid{P->h, P->mod + (size_t)l * 5 * 6 * D + 5 * D, P->kv, (const float*)P->h})));
    }
    PHASE(13, phase_final(P));
#undef PHASE
}

constexpr int N_PHASES = 1 + 2 * (1 + 3 + 4) + 2 * (1 + 4 + 4) + 1;

extern "C" void kernel_launch(void* const* d_in, const int* in_sizes, int n_in, void* d_out, int out_size, void* d_ws, size_t ws_size, hipStream_t stream) {
    static int grid = 0;
    if (grid == 0) {
        if (n_in != 30 || out_size != MLAT * D || ws_size < WS_END) {
            fprintf(stderr, "kernel_launch: unexpected sizes n_in %d out %d ws %zu (need %zu)\n", n_in, out_size, ws_size, (size_t)WS_END); grid = -1; return;
        }
        int dev = 0, cus = 0, per_cu = 0;
        if (hipGetDevice(&dev) != hipSuccess || hipDeviceGetAttribute(&cus, hipDeviceAttributeMultiprocessorCount, dev) != hipSuccess) { grid = -1; return; }
        if (hipFuncSetAttribute((const void*)mega, hipFuncAttributeMaxDynamicSharedMemorySize, LDS_BYTES) != hipSuccess) { fprintf(stderr, "kernel_launch: hipFuncSetAttribute failed\n"); grid = -1; return; }
        if (hipOccupancyMaxActiveBlocksPerMultiprocessor(&per_cu, (const void*)mega, NTHR, LDS_BYTES) != hipSuccess || per_cu < 1)
            fprintf(stderr, "kernel_launch: occupancy query reports %d blocks per CU\n", per_cu);
        (void)hipGetLastError();
        grid = cus;
    }
    if (grid < 0) return;
    (void)hipMemsetAsync((char*)d_ws + WS_BAR, 0, XCD_BAR_WORDS * 4, stream);
    Params P; memset(&P, 0, sizeof(P));
    const float** ip = (const float**)&P;
    for (int i = 0; i < 30; ++i) ip[i] = (const float*)d_in[i];
    P.out = (float*)d_out;
    char* ws = (char*)d_ws;
    P.bar = (unsigned*)(ws + WS_BAR);
    P.mod = (float*)(ws + WS_MOD); P.lb = (float*)(ws + WS_LB); P.rope = (float*)(ws + WS_ROPE);
    P.h = (float*)(ws + WS_H); P.a = (bf16_t*)(ws + WS_A); P.p = (bf16_t*)(ws + WS_P); P.kv = (float*)(ws + WS_KV);
    P.ckvn = (bf16_t*)(ws + WS_CKVN); P.y = (bf16_t*)(ws + WS_Y); P.u = (bf16_t*)(ws + WS_U); P.filt_lat = (float*)(ws + WS_FLAT); P.filt_ctx = (float*)(ws + WS_FCTX);
    P.zb = (float*)(ws + WS_ZB); P.x0b = (float*)(ws + WS_X0B); P.of = (float*)(ws + WS_OF); P.ob = (float*)(ws + WS_OB);
    P.wt_ev = (bf16_t*)(ws + WS_WEV); P.wt_od = (bf16_t*)(ws + WS_WOD); P.wt_ukv = (bf16_t*)(ws + WS_WUKV); P.wt_out = (bf16_t*)(ws + WS_WOUT);
    P.wt_w1 = (bf16_t*)(ws + WS_WW1); P.wt_w2 = (bf16_t*)(ws + WS_WW2);
    P.qm = (bf16_t*)(ws + WS_QM); P.km = (bf16_t*)(ws + WS_KM); P.vm = (bf16_t*)(ws + WS_VM);
    P.qn = (bf16_t*)(ws + WS_QN); P.kn = (bf16_t*)(ws + WS_KN); P.vn = (bf16_t*)(ws + WS_VN);
    P.kf = (float2*)(ws + WS_KF); P.ckv = (bf16_t*)(ws + WS_CKV); P.kpe = (bf16_t*)(ws + WS_KPE); P.hq = (bf16_t*)(ws + WS_HQ); P.hu = (bf16_t*)(ws + WS_HU); P.he = (float*)(ws + WS_HE); P.ssq = (float*)(ws + WS_SSQ);
#if MK_MULTI
    for (int i = 0; i < N_PHASES; ++i) {
        P.ph_lo = i; P.ph_hi = i + 1;
        hipLaunchKernelGGL(mega, dim3(grid), dim3(NTHR), LDS_BYTES, stream, P);
    }
#else
    P.ph_lo = 0; P.ph_hi = N_PHASES;
    hipLaunchKernelGGL(mega, dim3(grid), dim3(NTHR), LDS_BYTES, stream, P);
#endif
    const hipError_t le = hipPeekAtLastError();
    if (le != hipSuccess) fprintf(stderr, "kernel_launch: launch failed: %s\n", hipGetErrorName(le));
}
```
